# Optimizing an MI355X kernel written in HIP

```python
import jax, jax.numpy as jnp
from jax import lax
import numpy as np

D_MODEL = 1024
BATCH = 8
SEQ = 2048
DEPTH = 2

EPS = 1e-6
N_BRANCHES = 2

GM_GROUPS = 8
GM_GROUP_CH = D_MODEL // GM_GROUPS
GM_WIDTH = GM_GROUPS * GM_GROUP_CH
GM_CHUNK = 128

MLA_HEADS = 16
QK_NOPE = 64
QK_ROPE = 32
QK_DIM = QK_NOPE + QK_ROPE
V_DIM = 64
Q_LORA = D_MODEL // 2
KV_LORA = D_MODEL // 4
ROPE_THETA = 10000.0
ATT_BLOCK = 128

OFF_U = 0
OFF_V = OFF_U + GM_WIDTH
OFF_CQ = OFF_V + GM_WIDTH
OFF_CKV = OFF_CQ + Q_LORA
OFF_KR = OFF_CKV + KV_LORA
OFF_GATE = OFF_KR + QK_ROPE
D_IN = OFF_GATE + N_BRANCHES * D_MODEL

DENSE_FF = 2816
N_EXPERTS = 8
TOP_K = 2
EXPERT_FF = 2816
NUM_DENSE = (DEPTH + 1) // 2
NUM_MOE = DEPTH // 2

kernel_name = "hybrid_gmlp_mla_gated_moe_block"


def rms_norm(x, g):
    xf = x.astype(jnp.float32)
    y = xf * lax.rsqrt(jnp.mean(xf * xf, axis=-1, keepdims=True) + EPS)
    return (y * g.astype(jnp.float32)).astype(x.dtype)


def layer_norm(x, g, b):
    xf = x.astype(jnp.float32)
    mu = jnp.mean(xf, axis=-1, keepdims=True)
    xc = xf - mu
    y = xc * lax.rsqrt(jnp.mean(xc * xc, axis=-1, keepdims=True) + EPS)
    return (y * g.astype(jnp.float32) + b.astype(jnp.float32)).astype(x.dtype)


def rope_tables(seq_len):
    pos = jnp.arange(seq_len, dtype=jnp.float32)
    inv_freq = ROPE_THETA ** (-jnp.arange(0, QK_ROPE, 2, dtype=jnp.float32) / QK_ROPE)
    ang = pos[:, None] * inv_freq[None, :]
    return jnp.cos(ang), jnp.sin(ang)


def apply_rope(x, cos, sin):
    c = cos[None, :, None, :].astype(x.dtype)
    s = sin[None, :, None, :].astype(x.dtype)
    x1, x2 = jnp.split(x, 2, axis=-1)
    return jnp.concatenate([x1 * c - x2 * s, x2 * c + x1 * s], axis=-1)


def swiglu(h, w_gu, w_down):
    g, u = jnp.split(h @ w_gu, 2, axis=-1)
    return (jax.nn.silu(g) * u) @ w_down


def gmlp_branch(a_u, a_v, v_g, v_b, w_s, b_s):
    B, S, _ = a_u.shape
    u = jax.nn.gelu(a_u)
    v = layer_norm(jax.nn.gelu(a_v), v_g, v_b)
    vc = v.reshape(B, S // GM_CHUNK, GM_CHUNK, GM_GROUPS, GM_GROUP_CH)
    causal = jnp.tril(jnp.ones((GM_CHUNK, GM_CHUNK), dtype=bool))
    ws = jnp.where(causal[None], w_s, jnp.zeros((), w_s.dtype))
    mixed = jnp.einsum('gts,bcsgd->bctgd', ws, vc) + b_s.T[None, None, :, :, None]
    return u * mixed.reshape(B, S, GM_WIDTH)


def causal_block_attention(q, k, v):
    B, S, H, Dq = q.shape
    nb = S // ATT_BLOCK
    scale = 1.0 / float(np.sqrt(Dq))
    qb = q.reshape(B, nb, ATT_BLOCK, H, Dq).transpose(1, 0, 2, 3, 4)
    kpos = jnp.arange(S)

    def one_block(args):
        q_blk, i = args
        qpos = i * ATT_BLOCK + jnp.arange(ATT_BLOCK)
        s = jnp.einsum('bqhd,bkhd->bhqk', q_blk, k, preferred_element_type=jnp.float32) * scale
        s = jnp.where(kpos[None, :] <= qpos[:, None], s, jnp.float32(-1e30))
        p = jax.nn.softmax(s, axis=-1).astype(v.dtype)
        return jnp.einsum('bhqk,bkhd->bqhd', p, v)

    out = lax.map(one_block, (qb, jnp.arange(nb)))
    return out.transpose(1, 0, 2, 3, 4).reshape(B, S, H * v.shape[-1])


def mla_branch(c_q, c_kv, k_r, q_lat_g, w_uq, kv_lat_g, w_ukv, q_norm_g, k_norm_g, cos, sin):
    B, S, _ = c_q.shape
    q = (rms_norm(c_q, q_lat_g) @ w_uq).reshape(B, S, MLA_HEADS, QK_DIM)
    kv = (rms_norm(c_kv, kv_lat_g) @ w_ukv).reshape(B, S, MLA_HEADS, QK_NOPE + V_DIM)
    k_nope, v = kv[..., :QK_NOPE], kv[..., QK_NOPE:]
    k_rope = jnp.broadcast_to(k_r[:, :, None, :], (B, S, MLA_HEADS, QK_ROPE))
    k = jnp.concatenate([k_nope, k_rope], axis=-1)
    q = rms_norm(q, q_norm_g)
    k = rms_norm(k, k_norm_g)
    q = jnp.concatenate([q[..., :QK_NOPE], apply_rope(q[..., QK_NOPE:], cos, sin)], axis=-1)
    k = jnp.concatenate([k[..., :QK_NOPE], apply_rope(k[..., QK_NOPE:], cos, sin)], axis=-1)
    return causal_block_attention(q, k, v)


def moe_swiglu(h, w_router, b_router, w_gu, w_down):
    B, S, D = h.shape
    xf = h.reshape(B * S, D)
    logits = (xf @ w_router).astype(jnp.float32) + b_router.astype(jnp.float32)
    top_vals, top_idx = lax.top_k(logits, TOP_K)
    wts = jax.nn.softmax(top_vals, axis=-1)
    combine = jnp.sum(jax.nn.one_hot(top_idx, N_EXPERTS, dtype=jnp.float32) * wts[..., None], axis=1)
    combine = combine.astype(h.dtype)
    y = jnp.zeros_like(xf)
    for e in range(N_EXPERTS):
        y = y + combine[:, e:e + 1] * swiglu(xf, w_gu[e], w_down[e])
    return y.reshape(B, S, D)


def setup_inputs(seed: int = 0) -> dict:
    key = jax.random.key(seed)
    ks = iter(jax.random.split(key, 32))

    def nrm(shape, fan_in):
        return jax.random.normal(next(ks), shape, jnp.float32) * (fan_in ** -0.5)

    def gain(shape):
        return 1.0 + 0.05 * jax.random.normal(next(ks), shape, jnp.float32)

    L = DEPTH
    return {
        "x": jax.random.normal(next(ks), (BATCH, SEQ, D_MODEL), jnp.float32),
        "mix_norm_g": gain((L, D_MODEL)),
        "w_in": nrm((L, D_MODEL, D_IN), D_MODEL),
        "gm_v_norm_g": gain((L, GM_WIDTH)),
        "gm_v_norm_b": 0.02 * jax.random.normal(next(ks), (L, GM_WIDTH), jnp.float32),
        "gm_w_spatial": nrm((L, GM_GROUPS, GM_CHUNK, GM_CHUNK), GM_CHUNK),
        "gm_b_spatial": gain((L, GM_GROUPS, GM_CHUNK)),
        "gm_w_proj": nrm((L, GM_WIDTH, D_MODEL), GM_WIDTH),
        "mla_q_lat_g": gain((L, Q_LORA)),
        "mla_w_uq": nrm((L, Q_LORA, MLA_HEADS * QK_DIM), Q_LORA),
        "mla_kv_lat_g": gain((L, KV_LORA)),
        "mla_w_ukv": nrm((L, KV_LORA, MLA_HEADS * (QK_NOPE + V_DIM)), KV_LORA),
        "mla_q_norm_g": gain((L, QK_DIM)),
        "mla_k_norm_g": gain((L, QK_DIM)),
        "mla_w_proj": nrm((L, MLA_HEADS * V_DIM, D_MODEL), MLA_HEADS * V_DIM),
        "w_out": nrm((L, D_MODEL, D_MODEL), D_MODEL),
        "ffn_norm_g": gain((L, D_MODEL)),
        "dense_w_gu": nrm((NUM_DENSE, D_MODEL, 2 * DENSE_FF), D_MODEL),
        "dense_w_down": nrm((NUM_DENSE, DENSE_FF, D_MODEL), DENSE_FF),
        "moe_w_router": nrm((NUM_MOE, D_MODEL, N_EXPERTS), D_MODEL),
        "moe_b_router": 0.01 * jax.random.normal(next(ks), (NUM_MOE, N_EXPERTS), jnp.float32),
        "moe_w_gu": nrm((NUM_MOE, N_EXPERTS, D_MODEL, 2 * EXPERT_FF), D_MODEL),
        "moe_w_down": nrm((NUM_MOE, N_EXPERTS, EXPERT_FF, D_MODEL), EXPERT_FF),
    }


def reference(x, mix_norm_g, w_in, gm_v_norm_g, gm_v_norm_b, gm_w_spatial, gm_b_spatial, gm_w_proj,
              mla_q_lat_g, mla_w_uq, mla_kv_lat_g, mla_w_ukv, mla_q_norm_g, mla_k_norm_g, mla_w_proj,
              w_out, ffn_norm_g, dense_w_gu, dense_w_down, moe_w_router, moe_b_router, moe_w_gu, moe_w_down):
    B, S, D = x.shape
    cos, sin = rope_tables(S)
    for l in range(DEPTH):
        h = rms_norm(x, mix_norm_g[l])
        z = h @ w_in[l]
        y_a = gmlp_branch(z[..., OFF_U:OFF_V], z[..., OFF_V:OFF_CQ],
                          gm_v_norm_g[l], gm_v_norm_b[l], gm_w_spatial[l], gm_b_spatial[l]) @ gm_w_proj[l]
        y_b = mla_branch(z[..., OFF_CQ:OFF_CKV], z[..., OFF_CKV:OFF_KR], z[..., OFF_KR:OFF_GATE],
                         mla_q_lat_g[l], mla_w_uq[l], mla_kv_lat_g[l], mla_w_ukv[l],
                         mla_q_norm_g[l], mla_k_norm_g[l], cos, sin) @ mla_w_proj[l]
        gates = jax.nn.sigmoid(z[..., OFF_GATE:].reshape(B, S, N_BRANCHES, D))
        merged = gates[..., 0, :] * y_a + gates[..., 1, :] * y_b
        x = x + merged @ w_out[l]
        h2 = rms_norm(x, ffn_norm_g[l])
        if l % 2 == 0:
            x = x + swiglu(h2, dense_w_gu[l // 2], dense_w_down[l // 2])
        else:
            m = l // 2
            x = x + moe_swiglu(h2, moe_w_router[m], moe_b_router[m], moe_w_gu[m], moe_w_down[m])
    return x
```

```cpp
#include <hip/hip_runtime.h>
#include <cstdio>
#include <cstdint>
#include <type_traits>

#ifndef ACT8_WIDE
#define ACT8_WIDE 1
#endif
#ifndef RES_BF16
#define RES_BF16 1
#endif
#define LAS __attribute__((address_space(3)))
#define GAS __attribute__((address_space(1)))
typedef unsigned short bf16_t;
typedef short bf16x8 __attribute__((ext_vector_type(8)));
typedef short s16x4 __attribute__((ext_vector_type(4)));
typedef float f32x4 __attribute__((ext_vector_type(4)));
typedef float f32x2 __attribute__((ext_vector_type(2)));
typedef float f32x16 __attribute__((ext_vector_type(16)));
typedef unsigned u32x4 __attribute__((ext_vector_type(4)));
typedef unsigned u32x2 __attribute__((ext_vector_type(2)));
typedef GAS unsigned gu32;
typedef int v4i32 __attribute__((ext_vector_type(4)));
typedef int v8i32 __attribute__((ext_vector_type(8)));

constexpr int M = 16384, D = 1024, SEQ = 2048, NBATCH = 8, NH = 16, DQK = 96, DV = 64, QL = 512, KVL = 256, FF = 2816, NE = 8, DIN = 4896;
constexpr int N1 = 5120;
constexpr int NQ = 2048, NKV = 2048;
constexpr int SLOTS = 32768 + 2048;
constexpr float EPS = 1e-6f;
#ifndef MOE_FP8
#define MOE_FP8 1
#endif
constexpr int MESZ = MOE_FP8 ? 1 : 2;
constexpr float W8_SCALE = MOE_FP8 ? 64.0f : 1.0f;
constexpr float C2 = 0.10206207261596577f * 1.4426950408889634f;

constexpr size_t MiB = 1u << 20;
constexpr size_t WS_CTL = 0, CTL_ZERO_BYTES = 1 * MiB;
constexpr size_t WS_ROPE = 1 * MiB;
constexpr size_t WS_XSSP = WS_ROPE + 256 * 1024;
constexpr size_t WS_TOKPOS = WS_ROPE + 512 * 1024;
constexpr size_t WS_VSTP = 2 * MiB;
constexpr size_t WS_CQP = 4 * MiB;
constexpr size_t WS_CKVP = 4 * MiB + 512 * 1024;
constexpr size_t WS_KRSS = 4 * MiB + 768 * 1024;
constexpr size_t WS_KR = 5 * MiB;
constexpr size_t WS_IDXT = 7 * MiB;
constexpr size_t WS_IDXW = 7 * MiB + 512 * 1024;
constexpr size_t WS_WL = 8 * MiB, WL_STRIDE = 19 * MiB;
constexpr size_t WL_W1T = 0, WL_WUQ = 10 * MiB, WL_WUKV = 12 * MiB, WL_PA = 13 * MiB, WL_PB = 15 * MiB, WL_WOUT = 17 * MiB;
constexpr size_t WS_WGU = 46 * MiB;
constexpr size_t WS_WD = 57 * MiB;
constexpr size_t WS_MGU = 63 * MiB;
constexpr size_t WS_MD = 151 * MiB;
constexpr size_t WS_XB = 195 * MiB;
constexpr size_t WS_X2 = 227 * MiB;
constexpr size_t WS_U = 291 * MiB, WS_VG = 323 * MiB, WS_G = 355 * MiB, WS_Q = 419 * MiB, WS_KT = 467 * MiB, WS_VT = 515 * MiB;
constexpr size_t WS_AO = 547 * MiB, WS_O = 579 * MiB, WS_CQ = 611 * MiB, WS_CKV = 627 * MiB, WS_IDXR = 635 * MiB  , WS_END = 636 * MiB;
constexpr int AOO_LD = 2048;
constexpr size_t WS_T = WS_U;
constexpr size_t WS_MG = WS_Q;
constexpr size_t WS_X1 = WS_G;
constexpr size_t WS_ACT = WS_Q;
constexpr size_t WS_ACT2 = WS_U;
static_assert(WS_ACT + (size_t)M * FF * 2 <= WS_AO, "ACT overlay");
static_assert(WS_ACT2 + (size_t)SLOTS * FF * 2 <= WS_VT, "ACT2 overlay");
constexpr size_t WS_XB8 = 616 * MiB;
constexpr size_t WS_Y = 480 * MiB;
static_assert(WS_ACT2 + (size_t)SLOTS * FF * 2 <= WS_Y && WS_Y + (size_t)2 * SLOTS * D * 2 <= WS_END, "Y overlay");
constexpr int CW_BAR = 4096, CW_CNT = 16384  , CW_DBG = 32768;

constexpr int RING_BYTES = 131072;
constexpr int XCH_OFF = RING_BYTES;
constexpr int MISC_OFF = RING_BYTES + 4096;
constexpr int LDS_BYTES = 147456;

typedef __bf16 bf16x2_t __attribute__((ext_vector_type(2)));
__device__ __forceinline__ unsigned cvt_pk_bf16(float lo, float hi) { f32x2 v = {lo, hi}; bf16x2_t b = __builtin_convertvector(v, bf16x2_t); return __builtin_bit_cast(unsigned, b); }
__device__ __forceinline__ float bf_lo(unsigned u) { return __uint_as_float(u << 16); }
__device__ __forceinline__ float bf_hi(unsigned u) { return __uint_as_float(u & 0xffff0000u); }
__device__ __forceinline__ float bf1(bf16_t b) { return __uint_as_float(((unsigned)b) << 16); }
__device__ __forceinline__ float fexp2(float x) { return __builtin_amdgcn_exp2f(x); }
__device__ __forceinline__ float frcp(float x) { return __builtin_amdgcn_rcpf(x); }
__device__ __forceinline__ float frsq(float x) { return __builtin_amdgcn_rsqf(x); }
__device__ __forceinline__ float gelu_t(float v) { return v * frcp(1.0f + fexp2(-2.3022082f * v * (1.0f + 0.044715f * v * v))); }
__device__ __forceinline__ float sigm(float v) { return frcp(1.0f + fexp2(-1.4426950409f * v)); }
__device__ __forceinline__ f32x2 sigm2(f32x2 v) { const f32x2 t = v * (-1.4426950409f); f32x2 e; e.x = fexp2(t.x); e.y = fexp2(t.y); const f32x2 d = e + 1.0f; f32x2 r; r.x = frcp(d.x); r.y = frcp(d.y); return r; }
__device__ __forceinline__ f32x2 gelu2(f32x2 v) { const f32x2 u = v * (v * v * 0.044715f + 1.0f); return v * sigm2(u * 1.5957691216f); }
__device__ __forceinline__ f32x4 gelu4(f32x4 a) { const f32x2 lo = gelu2((f32x2){a.x, a.y}), hi = gelu2((f32x2){a.z, a.w}); return (f32x4){lo.x, lo.y, hi.x, hi.y}; }
__device__ __forceinline__ f32x4 sigm4(f32x4 a) { const f32x2 lo = sigm2((f32x2){a.x, a.y}), hi = sigm2((f32x2){a.z, a.w}); return (f32x4){lo.x, lo.y, hi.x, hi.y}; }
__device__ __forceinline__ int crow(int r, int hi) { return (r & 3) + 8 * (r >> 2) + 4 * hi; }
#define LDS_WAIT() asm volatile("s_waitcnt lgkmcnt(0)" ::: "memory")
#define VM_WAIT() asm volatile("s_waitcnt vmcnt(0)" ::: "memory")
#define RAW_BAR() do { asm volatile("" ::: "memory"); __builtin_amdgcn_s_barrier(); asm volatile("" ::: "memory"); } while (0)

namespace pg8 {
constexpr int BM = 256, BK = 64, HALF = 128, HTB = HALF * BK * 2, STAGE_BYTES = 8 * HTB, NXCD = 8, WGM = 8;
__host__ __device__ __forceinline__ int lds_byte(int r, int c) { const int st = (r >> 4) * 2 + (c >> 5), rr = r & 15, cc = c & 31, ob = rr * 64 + cc * 2; return st * 1024 + (ob ^ (((ob >> 9) & 1) << 5)); }
__host__ __device__ __forceinline__ void stage_rc(int b, int& R, int& C) { const int st = b / 1024, sb = b % 1024, swz = sb ^ (((sb >> 9) & 1) << 5); R = (st >> 1) * 16 + swz / 64; C = (st & 1) * 32 + (swz % 64) / 2; }
__host__ __device__ __forceinline__ int perm32(int rho) { const int n = rho >> 4, i = rho & 15; return 8 * (i >> 2) + 4 * n + (i & 3); }
struct Unit { int pm, pn, e, p0, cn, nt; };
struct StaticOrder {
    int nM, nN, nwg, G, c;
    __device__ __forceinline__ void init(int nM_, int nN_, int G_, int c_) { nM = nM_; nN = nN_; nwg = nM * nN; G = G_; c = c_; }
    __device__ __forceinline__ bool next(int i, Unit& u) const {
        const long L = (long)i * G + c; if (L >= nwg) return false;
        int wgid = (int)L; { const int q = nwg / NXCD, r = nwg % NXCD, xcd = wgid % NXCD, off = wgid / NXCD; wgid = (xcd < r ? xcd * (q + 1) : r * (q + 1) + (xcd - r) * q) + off; }
        const int nig = WGM * nN, gid = wgid / nig, fm = gid * WGM, gsz = (nM - fm) < WGM ? (nM - fm) : WGM;
        u.pm = fm + ((wgid % nig) % gsz); u.pn = (wgid % nig) / gsz; u.e = 0; u.p0 = 0; u.cn = 0; u.nt = 0; return true;
    }
};
template <class T, class = void> struct HasMid : std::false_type {};
template <class T> struct HasMid<T, std::void_t<decltype(&T::mid)>> : std::true_type {};
template <class Epi, class Sched, bool ALIGN_EPI, bool GATHER>
__device__ __forceinline__ void gemm_phase(LAS unsigned char* lds, const int K, const int lda, const int ldb, const Sched& S, const Epi& E) {
    int tid = threadIdx.x; asm volatile("" : "+v"(tid));
    const int wid = __builtin_amdgcn_readfirstlane(tid >> 6), lane = tid & 63, wr = wid >> 2, wc = wid & 3, fr = lane & 15, fq = lane >> 4;
    int nt = K / BK; asm volatile("" : "+s"(nt));
    int Rr[2], Cc[2]; unsigned voffB[2];
#pragma unroll
    for (int i = 0; i < 2; ++i) { stage_rc(tid * 16 + i * 8192, Rr[i], Cc[i]); const int Rb = (Rr[i] & ~31) + perm32(Rr[i] & 31); voffB[i] = (unsigned)(Rb * ldb + Cc[i]) * 2u; }
    const size_t kstep = (size_t)(BK * 2);
    const size_t hstepB = (size_t)HALF * ldb * 2;
    const unsigned ldsw = (unsigned)wid * 1024u;
    const int aoff = lds_byte(wr * 64 + fr, fq * 8), boff = lds_byte(wc * 32 + fr, fq * 8);
#define PG8_SA(b, h) (((b) * 2 + (h)) * HTB)
#define PG8_SB(b, h) ((4 + (b) * 2 + (h)) * HTB)
#define PG8_STAGE(bufoff, gbase, voff) do { _Pragma("unroll") for (int _i = 0; _i < 2; ++_i) \
        __builtin_amdgcn_global_load_lds((const unsigned*)((const char*)(gbase) + (voff)[_i]), (LAS unsigned*)(lds + (bufoff) + ldsw + _i * 8192), 16, 0, 0); } while (0)
#define PG8_LDA(dst, b, h) do { _Pragma("unroll") for (int m = 0; m < 4; ++m) _Pragma("unroll") for (int k = 0; k < 2; ++k) dst[m][k] = *(const LAS bf16x8*)(lds + PG8_SA(b, h) + aoff + m * 2048 + k * 1024); } while (0)
#define PG8_LDB(dst, b, h) do { _Pragma("unroll") for (int n = 0; n < 2; ++n) _Pragma("unroll") for (int k = 0; k < 2; ++k) dst[n][k] = *(const LAS bf16x8*)(lds + PG8_SB(b, h) + boff + n * 2048 + k * 1024); } while (0)
#define PG8_MMA(ai, bj, At, Bt) do { __builtin_amdgcn_s_setprio(1); _Pragma("unroll") for (int m = 0; m < 4; ++m) _Pragma("unroll") for (int n = 0; n < 2; ++n) _Pragma("unroll") for (int k = 0; k < 2; ++k) \
        acc[ai][bj][m][n] = __builtin_amdgcn_mfma_f32_16x16x32_bf16(Bt[n][k], At[m][k], acc[ai][bj][m][n], 0, 0, 0); __builtin_amdgcn_s_setprio(0); } while (0)
#define PG8_WAIT_V(n) asm volatile("s_waitcnt vmcnt(" #n ")" ::: "memory")
#define PG8_WAIT_L(n) asm volatile("s_waitcnt lgkmcnt(" #n ")" ::: "memory")
#define PG8_BAR __builtin_amdgcn_s_barrier()
#define PG8_SCHED __builtin_amdgcn_sched_barrier(0)
#define PG8_SETVO(V, U_) do { _Pragma("unroll") for (int _h = 0; _h < 2; ++_h) _Pragma("unroll") for (int _i = 0; _i < 2; ++_i) { \
        const int _rl = _h * HALF + Rr[_i]; const int _row = GATHER ? S.tok(U_, _rl) : _rl; V[_h][_i] = (unsigned)(_row * lda + Cc[_i]) * 2u; } } while (0)
    Unit cur, nxt; int ui = 0;
    if (!S.next(0, cur)) return;
    if (cur.nt > 0) { nt = cur.nt; asm volatile("" : "+s"(nt)); }
    f32x4 acc[2][2][4][2];
#pragma unroll
    for (int a = 0; a < 2; ++a)
#pragma unroll
        for (int b = 0; b < 2; ++b)
#pragma unroll
            for (int m = 0; m < 4; ++m)
#pragma unroll
                for (int n = 0; n < 2; ++n) acc[a][b][m][n] = (f32x4){0.f, 0.f, 0.f, 0.f};
    bf16x8 At[4][2], B0[2][2], B1[2][2];
    unsigned vo[2][2], nvo[2][2];
    PG8_SETVO(vo, cur);
#pragma unroll
    for (int h = 0; h < 2; ++h)
#pragma unroll
        for (int i = 0; i < 2; ++i) nvo[h][i] = vo[h][i];
    const char* cA = S.abase(cur); const char* cB = S.bbase(cur);
    PG8_STAGE(PG8_SB(0, 0), cB, voffB); PG8_STAGE(PG8_SB(0, 1), cB + hstepB, voffB); PG8_STAGE(PG8_SA(0, 0), cA, vo[0]); PG8_STAGE(PG8_SA(0, 1), cA, vo[1]);
    if (wr == 1) PG8_BAR;
    PG8_WAIT_V(2); PG8_BAR;
    PG8_STAGE(PG8_SB(1, 0), cB + kstep, voffB); PG8_STAGE(PG8_SA(1, 0), cA + kstep, vo[0]); PG8_STAGE(PG8_SB(1, 1), cB + hstepB + kstep, voffB);
    PG8_WAIT_V(6); PG8_BAR;
    for (;;) {
        const bool has_next = S.next(ui + 1, nxt);
        const char* nA = has_next ? S.abase(nxt) : cA; const char* nB = has_next ? S.bbase(nxt) : cB;
        if (GATHER) { if (has_next) PG8_SETVO(nvo, nxt); }
        for (int t = 0; t < nt; t += 2) {
            if constexpr (HasMid<Epi>::value) { if (t == (nt >> 1)) { asm volatile("" ::: "memory"); E.mid(acc, cur, wr, wc, fr, fq); asm volatile("" ::: "memory"); } }
            const bool last = (t == nt - 2);
            const char* a1 = cA + (size_t)(t + 1) * kstep;
            const char* a2 = last ? nA : cA + (size_t)(t + 2) * kstep; const char* b2 = last ? nB : cB + (size_t)(t + 2) * kstep;
            const char* a3 = a2 + kstep; const char* b3 = b2 + kstep;
            unsigned v2[2][2];
#pragma unroll
            for (int h = 0; h < 2; ++h)
#pragma unroll
                for (int i = 0; i < 2; ++i) v2[h][i] = GATHER ? (last ? nvo[h][i] : vo[h][i]) : vo[h][i];
            PG8_LDB(B0, 0, 0); PG8_LDB(B1, 0, 1); PG8_SCHED; PG8_LDA(At, 0, 0); PG8_STAGE(PG8_SA(1, 1), a1, vo[1]);
            PG8_WAIT_V(8); PG8_WAIT_L(0); PG8_BAR; PG8_MMA(0, 0, At, B0); PG8_MMA(0, 1, At, B1); PG8_BAR; PG8_SCHED;
            PG8_LDA(At, 0, 1); PG8_STAGE(PG8_SB(0, 0), b2, voffB); PG8_STAGE(PG8_SB(0, 1), b2 + hstepB, voffB); PG8_STAGE(PG8_SA(0, 0), a2, v2[0]);
            PG8_WAIT_V(8); PG8_WAIT_L(0); PG8_BAR; PG8_MMA(1, 0, At, B0); PG8_MMA(1, 1, At, B1); PG8_BAR; PG8_SCHED;
            PG8_LDB(B0, 1, 0); PG8_LDB(B1, 1, 1); PG8_SCHED; PG8_LDA(At, 1, 0); PG8_STAGE(PG8_SA(0, 1), a2, v2[1]);
            PG8_WAIT_V(8); PG8_WAIT_L(0); PG8_BAR; PG8_MMA(0, 0, At, B0); PG8_MMA(0, 1, At, B1); PG8_BAR; PG8_SCHED;
            PG8_LDA(At, 1, 1); PG8_STAGE(PG8_SB(1, 0), b3, voffB); PG8_STAGE(PG8_SB(1, 1), b3 + hstepB, voffB); PG8_STAGE(PG8_SA(1, 0), a3, v2[0]);
            PG8_WAIT_V(8); PG8_WAIT_L(0); PG8_BAR; PG8_MMA(1, 0, At, B0); PG8_MMA(1, 1, At, B1); PG8_BAR; PG8_SCHED;
        }
        if constexpr (ALIGN_EPI) { if (wr == 0) PG8_BAR; }
        asm volatile("" ::: "memory");
        if constexpr (!Epi::AFTER_DRAIN) { E(acc, cur, wr, wc, fr, fq, lds); }
        asm volatile("" ::: "memory");
        if (!has_next) break;
#pragma unroll
        for (int a = 0; a < 2; ++a)
#pragma unroll
            for (int b = 0; b < 2; ++b)
#pragma unroll
                for (int m = 0; m < 4; ++m)
#pragma unroll
                    for (int n = 0; n < 2; ++n) acc[a][b][m][n] = (f32x4){0.f, 0.f, 0.f, 0.f};
        cur = nxt; cA = nA; cB = nB; ++ui; if (cur.nt > 0) { nt = cur.nt; asm volatile("" : "+s"(nt)); }
        if (GATHER) {
#pragma unroll
            for (int h = 0; h < 2; ++h)
#pragma unroll
                for (int i = 0; i < 2; ++i) vo[h][i] = nvo[h][i];
        }
        if constexpr (ALIGN_EPI) { if (wr == 1) PG8_BAR; }
    }
    PG8_WAIT_V(0);
    if constexpr (!ALIGN_EPI) { if (wr == 0) PG8_BAR; }
    PG8_BAR;
    asm volatile("" ::: "memory");
    if constexpr (Epi::AFTER_DRAIN) { E.fused(acc, cur, wr, wc, fr, fq, lds, wid, lane); }
    asm volatile("" ::: "memory");
#undef PG8_SA
#undef PG8_SB
#undef PG8_STAGE
#undef PG8_LDA
#undef PG8_LDB
#undef PG8_MMA
#undef PG8_WAIT_V
#undef PG8_WAIT_L
#undef PG8_BAR
#undef PG8_SCHED
#undef PG8_SETVO
}
template <class Epi, class Sched, bool ALIGN_EPI, bool GATHER>
__device__ __forceinline__ void gemm_phase_f8(LAS unsigned char* lds, const int K, const int lda, const int ldb, const Sched& S, const Epi& E) {
    int tid = threadIdx.x; asm volatile("" : "+v"(tid));
    const int wid = __builtin_amdgcn_readfirstlane(tid >> 6), lane = tid & 63, wr = wid >> 2, wc = wid & 3, fr = lane & 15, fq = lane >> 4;
    int nt = K / (2 * BK); asm volatile("" : "+s"(nt));
    int Rr[2], Cc[2]; unsigned voffB[2];
#pragma unroll
    for (int i = 0; i < 2; ++i) { stage_rc(tid * 16 + i * 8192, Rr[i], Cc[i]); const int Rb = (Rr[i] & ~31) + perm32(Rr[i] & 31); voffB[i] = (unsigned)(Rb * ldb + Cc[i] * 2); }
    const size_t kstep = (size_t)(BK * 2);
    const size_t hstepB = (size_t)HALF * ldb;
    const unsigned ldsw = (unsigned)wid * 1024u;
    const int aoff = lds_byte(wr * 64 + fr, fq * 8), boff = lds_byte(wc * 32 + fr, fq * 8);
#define PG8_SA(b, h) (((b) * 2 + (h)) * HTB)
#define PG8_SB(b, h) ((4 + (b) * 2 + (h)) * HTB)
#define PG8_STAGE(bufoff, gbase, voff) do { _Pragma("unroll") for (int _i = 0; _i < 2; ++_i) \
        __builtin_amdgcn_global_load_lds((const unsigned*)((const char*)(gbase) + (voff)[_i]), (LAS unsigned*)(lds + (bufoff) + ldsw + _i * 8192), 16, 0, 0); } while (0)
#define PG8_LD16(off) (*(const LAS bf16x8*)(lds + (off)))
#define PG8_CAT8(lo, hi) __builtin_shufflevector(__builtin_bit_cast(v4i32, lo), __builtin_bit_cast(v4i32, hi), 0, 1, 2, 3, 4, 5, 6, 7)
#define PG8_LDA(dst, b, h) do { _Pragma("unroll") for (int m = 0; m < 4; ++m) dst[m] = PG8_CAT8(PG8_LD16(PG8_SA(b, h) + aoff + m * 2048), PG8_LD16(PG8_SA(b, h) + aoff + m * 2048 + 1024)); } while (0)
#define PG8_LDB(dst, b, h) do { _Pragma("unroll") for (int n = 0; n < 2; ++n) dst[n] = PG8_CAT8(PG8_LD16(PG8_SB(b, h) + boff + n * 2048), PG8_LD16(PG8_SB(b, h) + boff + n * 2048 + 1024)); } while (0)
#define PG8_MMA(ai, bj, At, Bt) do { __builtin_amdgcn_s_setprio(1); asm volatile("s_nop 1"); _Pragma("unroll") for (int m = 0; m < 4; ++m) _Pragma("unroll") for (int n = 0; n < 2; ++n) \
        asm volatile("v_mfma_f32_16x16x128_f8f6f4 %0, %1, %2, %0" : "+v"(acc[ai][bj][m][n]) : "v"(Bt[n]), "v"(At[m])); __builtin_amdgcn_s_setprio(0); } while (0)
#define PG8_WAIT_V(n) asm volatile("s_waitcnt vmcnt(" #n ")" ::: "memory")
#define PG8_WAIT_L(n) asm volatile("s_waitcnt lgkmcnt(" #n ")" ::: "memory")
#define PG8_BAR __builtin_amdgcn_s_barrier()
#define PG8_SCHED __builtin_amdgcn_sched_barrier(0)
#define PG8_SETVO(V, U_) do { int _row4[4]; if constexpr (GATHER) S.tok4(U_, Rr[0], Rr[1], _row4); \
        _Pragma("unroll") for (int _h = 0; _h < 2; ++_h) _Pragma("unroll") for (int _i = 0; _i < 2; ++_i) { \
        const int _rl = _h * HALF + Rr[_i]; const int _row = GATHER ? _row4[2 * _h + _i] : _rl; V[_h][_i] = (unsigned)(_row * lda + Cc[_i] * 2); } } while (0)
    Unit cur, nxt; int ui = 0;
    if (!S.next(0, cur)) return;
    if (cur.nt > 0) { nt = cur.nt; asm volatile("" : "+s"(nt)); }
    f32x4 acc[2][2][4][2];
#pragma unroll
    for (int a = 0; a < 2; ++a)
#pragma unroll
        for (int b = 0; b < 2; ++b)
#pragma unroll
            for (int m = 0; m < 4; ++m)
#pragma unroll
                for (int n = 0; n < 2; ++n) acc[a][b][m][n] = (f32x4){0.f, 0.f, 0.f, 0.f};
    v8i32 At[4], B0[2], B1[2];
    unsigned vo[2][2], nvo[2][2];
    PG8_SETVO(vo, cur);
#pragma unroll
    for (int h = 0; h < 2; ++h)
#pragma unroll
        for (int i = 0; i < 2; ++i) nvo[h][i] = vo[h][i];
    const char* cA = S.abase(cur); const char* cB = S.bbase(cur);
    PG8_STAGE(PG8_SB(0, 0), cB, voffB); PG8_STAGE(PG8_SB(0, 1), cB + hstepB, voffB); PG8_STAGE(PG8_SA(0, 0), cA, vo[0]); PG8_STAGE(PG8_SA(0, 1), cA, vo[1]);
    if (wr == 1) PG8_BAR;
    PG8_WAIT_V(2); PG8_BAR;
    PG8_STAGE(PG8_SB(1, 0), cB + kstep, voffB); PG8_STAGE(PG8_SA(1, 0), cA + kstep, vo[0]); PG8_STAGE(PG8_SB(1, 1), cB + hstepB + kstep, voffB);
    PG8_WAIT_V(6); PG8_BAR;
    for (;;) {
        const bool has_next = S.next(ui + 1, nxt);
        const char* nA = has_next ? S.abase(nxt) : cA; const char* nB = has_next ? S.bbase(nxt) : cB;
        if (GATHER) { if (has_next) PG8_SETVO(nvo, nxt); }
        for (int t = 0; t < nt; t += 2) {
            if constexpr (HasMid<Epi>::value) { if (t == (nt >> 1)) { asm volatile("" ::: "memory"); E.mid(acc, cur, wr, wc, fr, fq); asm volatile("" ::: "memory"); } }
            const bool last = (t == nt - 2);
            const char* a1 = cA + (size_t)(t + 1) * kstep;
            const char* a2 = last ? nA : cA + (size_t)(t + 2) * kstep; const char* b2 = last ? nB : cB + (size_t)(t + 2) * kstep;
            const char* a3 = a2 + kstep; const char* b3 = b2 + kstep;
            unsigned v2[2][2];
#pragma unroll
            for (int h = 0; h < 2; ++h)
#pragma unroll
                for (int i = 0; i < 2; ++i) v2[h][i] = GATHER ? (last ? nvo[h][i] : vo[h][i]) : vo[h][i];
            PG8_LDB(B0, 0, 0); PG8_LDB(B1, 0, 1); PG8_SCHED; PG8_LDA(At, 0, 0); PG8_STAGE(PG8_SA(1, 1), a1, vo[1]);
            PG8_WAIT_V(8); PG8_WAIT_L(0); PG8_BAR; PG8_MMA(0, 0, At, B0); PG8_MMA(0, 1, At, B1); PG8_BAR; PG8_SCHED;
            PG8_LDA(At, 0, 1); PG8_STAGE(PG8_SB(0, 0), b2, voffB); PG8_STAGE(PG8_SB(0, 1), b2 + hstepB, voffB); PG8_STAGE(PG8_SA(0, 0), a2, v2[0]);
            PG8_WAIT_V(8); PG8_WAIT_L(0); PG8_BAR; PG8_MMA(1, 0, At, B0); PG8_MMA(1, 1, At, B1); PG8_BAR; PG8_SCHED;
            PG8_LDB(B0, 1, 0); PG8_LDB(B1, 1, 1); PG8_SCHED; PG8_LDA(At, 1, 0); PG8_STAGE(PG8_SA(0, 1), a2, v2[1]);
            PG8_WAIT_V(8); PG8_WAIT_L(0); PG8_BAR; PG8_MMA(0, 0, At, B0); PG8_MMA(0, 1, At, B1); PG8_BAR; PG8_SCHED;
            PG8_LDA(At, 1, 1); PG8_STAGE(PG8_SB(1, 0), b3, voffB); PG8_STAGE(PG8_SB(1, 1), b3 + hstepB, voffB); PG8_STAGE(PG8_SA(1, 0), a3, v2[0]);
            PG8_WAIT_V(8); PG8_WAIT_L(0); PG8_BAR; PG8_MMA(1, 0, At, B0); PG8_MMA(1, 1, At, B1); PG8_BAR; PG8_SCHED;
        }
        if constexpr (ALIGN_EPI) { if (wr == 0) PG8_BAR; }
        asm volatile("s_nop 15\n\ts_nop 15" : "+v"(acc[0][0][0][0]), "+v"(acc[0][0][0][1]), "+v"(acc[0][0][1][0]), "+v"(acc[0][0][1][1]), "+v"(acc[0][0][2][0]), "+v"(acc[0][0][2][1]), "+v"(acc[0][0][3][0]), "+v"(acc[0][0][3][1]), "+v"(acc[0][1][0][0]), "+v"(acc[0][1][0][1]), "+v"(acc[0][1][1][0]), "+v"(acc[0][1][1][1]), "+v"(acc[0][1][2][0]), "+v"(acc[0][1][2][1]), "+v"(acc[0][1][3][0]), "+v"(acc[0][1][3][1]) :: "memory");
        asm volatile("" : "+v"(acc[1][0][0][0]), "+v"(acc[1][0][0][1]), "+v"(acc[1][0][1][0]), "+v"(acc[1][0][1][1]), "+v"(acc[1][0][2][0]), "+v"(acc[1][0][2][1]), "+v"(acc[1][0][3][0]), "+v"(acc[1][0][3][1]), "+v"(acc[1][1][0][0]), "+v"(acc[1][1][0][1]), "+v"(acc[1][1][1][0]), "+v"(acc[1][1][1][1]), "+v"(acc[1][1][2][0]), "+v"(acc[1][1][2][1]), "+v"(acc[1][1][3][0]), "+v"(acc[1][1][3][1]) :: "memory");
        if constexpr (!Epi::AFTER_DRAIN) { E(acc, cur, wr, wc, fr, fq, lds); }
        asm volatile("" ::: "memory");
        if (!has_next) break;
#pragma unroll
        for (int a = 0; a < 2; ++a)
#pragma unroll
            for (int b = 0; b < 2; ++b)
#pragma unroll
                for (int m = 0; m < 4; ++m)
#pragma unroll
                    for (int n = 0; n < 2; ++n) acc[a][b][m][n] = (f32x4){0.f, 0.f, 0.f, 0.f};
        cur = nxt; cA = nA; cB = nB; ++ui; if (cur.nt > 0) { nt = cur.nt; asm volatile("" : "+s"(nt)); }
        if (GATHER) {
#pragma unroll
            for (int h = 0; h < 2; ++h)
#pragma unroll
                for (int i = 0; i < 2; ++i) vo[h][i] = nvo[h][i];
        }
        if constexpr (ALIGN_EPI) { if (wr == 1) PG8_BAR; }
    }
    PG8_WAIT_V(0);
    if constexpr (!ALIGN_EPI) { if (wr == 0) PG8_BAR; }
    PG8_BAR;
    asm volatile("" ::: "memory");
    if constexpr (Epi::AFTER_DRAIN) { E.fused(acc, cur, wr, wc, fr, fq, lds, wid, lane); }
    asm volatile("" ::: "memory");
#undef PG8_SA
#undef PG8_SB
#undef PG8_STAGE
#undef PG8_LDA
#undef PG8_LD16
#undef PG8_CAT8
#undef PG8_LDB
#undef PG8_MMA
#undef PG8_WAIT_V
#undef PG8_WAIT_L
#undef PG8_BAR
#undef PG8_SCHED
#undef PG8_SETVO
}
}
using pg8::Unit;

struct SchedStd : pg8::StaticOrder {
    const char* A; const char* Bt; size_t astep, bstep;
    __device__ __forceinline__ const char* abase(const Unit& u) const { return A + (size_t)u.pm * astep; }
    __device__ __forceinline__ const char* bbase(const Unit& u) const { return Bt + (size_t)u.pn * bstep; }
    __device__ __forceinline__ int tok(const Unit&, int rl) const { return rl; }
};
__device__ __forceinline__ int moe_cnt(const unsigned* cntw, int e) { return (int)__builtin_amdgcn_readfirstlane((int)__hip_atomic_load(cntw + 64 * e, __ATOMIC_RELAXED, __HIP_MEMORY_SCOPE_AGENT)); }
__device__ __forceinline__ int moe_total_tiles(const unsigned* cntw) { int t = 0;
#pragma unroll
    for (int e = 0; e < 8; ++e) t += (moe_cnt(cntw, e) + 255) >> 8; return t; }
constexpr int MOE_TT_OFF = MISC_OFF + 1024, MOE_TT_N = 160;
typedef int i32x4 __attribute__((ext_vector_type(4)));
__device__ __forceinline__ void moe_table_build(LAS unsigned char* lds, const unsigned* cntw) {
    int tid = threadIdx.x; asm volatile("" : "+v"(tid));
    if (tid <= MOE_TT_N) { int c[8];
#pragma unroll
        for (int j = 0; j < 8; ++j) c[j] = (int)__hip_atomic_load(cntw + 64 * j, __ATOMIC_RELAXED, __HIP_MEMORY_SCOPE_AGENT);
        int acc = 0, e = 0, tse = 0, cn = 1;
#pragma unroll
        for (int j = 0; j < 8; ++j) { if (tid >= acc) { e = j; tse = acc; cn = c[j]; } acc += (c[j] + 255) >> 8; }
        *(LAS i32x4*)(lds + MOE_TT_OFF + 16 * tid) = (tid < MOE_TT_N) ? (i32x4){e, (tid - tse) * 256, cn, 0} : (i32x4){acc, 0, 0, 0}; }
    __syncthreads();
}
__device__ __forceinline__ int moe_table_tiles(LAS unsigned char* lds) { return __builtin_amdgcn_readfirstlane(*(const LAS int*)(lds + MOE_TT_OFF + 16 * MOE_TT_N)); }
__device__ __forceinline__ void moe_fill(LAS const unsigned char* tt, Unit& u) { const i32x4 v = *(const LAS i32x4*)(tt + 16 * u.pm);
    u.e = __builtin_amdgcn_readfirstlane(v.x); u.p0 = __builtin_amdgcn_readfirstlane(v.y); u.cn = __builtin_amdgcn_readfirstlane(v.z); }
struct SchedMoeGu : pg8::StaticOrder {
    const char* XB; const char* W; LAS const unsigned char* tt; const int* idxt;
    __device__ __forceinline__ bool next(int i, Unit& u) const { if (!pg8::StaticOrder::next(i, u)) return false; moe_fill(tt, u); return true; }
    __device__ __forceinline__ const char* abase(const Unit&) const { return XB; }
    __device__ __forceinline__ const char* bbase(const Unit& u) const { return W + (size_t)u.e * ((size_t)2 * FF * D * MESZ) + (size_t)u.pn * (256 * D * MESZ); }
    __device__ __forceinline__ int tok(const Unit& u, int rl) const { const int pos = u.p0 + rl; return idxt[u.e * M + (pos < u.cn ? pos : u.cn - 1)]; }
    __device__ __forceinline__ void tok4(const Unit& u, int r0, int r1, int (&out)[4]) const {
        const int* base = idxt + u.e * M; const int lim = u.cn - 1;
        int p[4] = {u.p0 + r0, u.p0 + r1, u.p0 + 128 + r0, u.p0 + 128 + r1};
#pragma unroll
        for (int i = 0; i < 4; ++i) p[i] = (p[i] < lim ? p[i] : lim) * 4;
        asm volatile("global_load_dword %0, %4, %8\n\tglobal_load_dword %1, %5, %8\n\tglobal_load_dword %2, %6, %8\n\tglobal_load_dword %3, %7, %8\n\ts_waitcnt vmcnt(0)"
                     : "=&v"(out[0]), "=&v"(out[1]), "=&v"(out[2]), "=&v"(out[3]) : "v"(p[0]), "v"(p[1]), "v"(p[2]), "v"(p[3]), "s"(base) : "memory");
    }
};
struct SchedMoeDn {
    const char* A; const char* W; LAS const unsigned char* tt; int RT, G, c;
    static constexpr int KTW = MOE_FP8 ? 22 : 44, KT0 = MOE_FP8 ? 10 : 22, KT1 = MOE_FP8 ? 12 : 22, RT0 = 128;
    __device__ __forceinline__ void init(int RT_, int G_, int c_) { RT = RT_; G = G_; c = c_; }
    __device__ __forceinline__ bool next(int i, Unit& u) const {
        const int L = i * G + c; const int nw = RT0 * 4;
        if (L < nw) { pg8::StaticOrder so; so.init(RT0, 4, G, c); if (!so.next(i, u)) return false; u.nt = KTW; }
        else { const int L2 = L - nw, n2 = (RT - RT0) * 8; if (L2 >= n2) return false;
            u.pm = RT0 + (L2 >> 3); u.pn = L2 & 7; u.nt = (u.pn >> 2) ? KT1 : KT0; }
        moe_fill(tt, u); return true;
    }
    __device__ __forceinline__ int kofs(const Unit& u) const { return (u.pm >= RT0 && (u.pn >> 2)) ? KT0 * 128 : 0; }
    __device__ __forceinline__ const char* abase(const Unit& u) const { return A + (size_t)u.pm * (256 * (size_t)FF * MESZ) + kofs(u); }
    __device__ __forceinline__ const char* bbase(const Unit& u) const { return W + (size_t)u.e * ((size_t)D * FF * MESZ) + (size_t)(u.pn & 3) * (256 * (size_t)FF * MESZ) + kofs(u); }
    __device__ __forceinline__ int tok(const Unit&, int rl) const { return rl; }
};

#define EPI_ROWS(ai, m) for (int ai = 0; ai < 2; ++ai) _Pragma("unroll") for (int m = 0; m < 4; ++m)
__device__ __forceinline__ float sum4(f32x4 v) { return (v.x + v.y) + (v.z + v.w); }
__device__ __forceinline__ float xsum16(float s) { return s + __uint_as_float((unsigned)__builtin_amdgcn_ds_swizzle((int)__float_as_uint(s), 0x401F)); }
__device__ __forceinline__ float xsum32(float s) { auto r = __builtin_amdgcn_permlane32_swap(__float_as_uint(s), __float_as_uint(s), false, false); return __uint_as_float(r[0]) + __uint_as_float(r[1]); }
__device__ __forceinline__ float xmax32(float s) { auto r = __builtin_amdgcn_permlane32_swap(__float_as_uint(s), __float_as_uint(s), false, false); return fmaxf(__uint_as_float(r[0]), __uint_as_float(r[1])); }
__device__ __forceinline__ float qsum(float s) { return xsum32(xsum16(s)); }
#define DPP_ROR_ADD(s, n) ((s) + __uint_as_float(__builtin_amdgcn_update_dpp(0u, __float_as_uint(s), 0x120 + (n), 0xf, 0xf, false)))
__device__ __forceinline__ float wave_sum(float s) { s = DPP_ROR_ADD(s, 8); s = DPP_ROR_ADD(s, 4); s = DPP_ROR_ADD(s, 2); s = DPP_ROR_ADD(s, 1); return xsum32(xsum16(s)); }
__device__ __forceinline__ u32x2 pack8_f8(f32x4 a, f32x4 b) { int w0 = 0, w1 = 0; w0 = __builtin_amdgcn_cvt_pk_fp8_f32(a.x, a.y, w0, false); w0 = __builtin_amdgcn_cvt_pk_fp8_f32(a.z, a.w, w0, true);
    w1 = __builtin_amdgcn_cvt_pk_fp8_f32(b.x, b.y, w1, false); w1 = __builtin_amdgcn_cvt_pk_fp8_f32(b.z, b.w, w1, true); return (u32x2){(unsigned)w0, (unsigned)w1}; }
__device__ __forceinline__ void st_wt(void* p, u32x4 v) { asm volatile("global_store_dwordx4 %0, %1, off sc1\n\ts_nop 1" :: "v"(p), "v"(v) : "memory"); }
__device__ __forceinline__ f32x4 ld_nt(const float* p) { return __builtin_nontemporal_load((const f32x4*)p); }
__device__ __forceinline__ u32x4 ld_nt(const bf16_t* p) { return __builtin_nontemporal_load((const u32x4*)p); }
__device__ __forceinline__ u32x4 pack8(f32x4 a, f32x4 b) { u32x4 w; w.x = cvt_pk_bf16(a.x, a.y); w.y = cvt_pk_bf16(a.z, a.w); w.z = cvt_pk_bf16(b.x, b.y); w.w = cvt_pk_bf16(b.z, b.w); return w; }

struct EpiG1 {
    static constexpr bool AFTER_DRAIN = false;
    const float* xssp; bf16_t *U, *Vg, *CQ, *CKV, *G; float *vstp, *cqp, *ckvp, *KR, *krss; const float* gk; const float *cosT, *sinT;
    __device__ __forceinline__ void operator()(f32x4 (&acc)[2][2][4][2], const Unit& u, int wr, int wc, int fr, int fq, LAS unsigned char*) const {
        int row0 = u.pm * 256 + wr * 64 + fr; asm volatile("" : "+v"(row0)); const int t = u.pn; const int pc = 32 * wc + 8 * fq;
        float rs[2][4]; { f32x4 xs_[2][4];
#pragma unroll
        EPI_ROWS(ai, m) { const int r = row0 + ai * 128 + m * 16; xs_[ai][m] = *(const f32x4*)(xssp + (size_t)r * 4); }
        __builtin_amdgcn_sched_barrier(0);
#pragma unroll
        EPI_ROWS(ai, m) rs[ai][m] = frsq(sum4(xs_[ai][m]) * (1.0f / D) + EPS); }
        if (t < 4) {
#pragma unroll
            EPI_ROWS(ai, m) { const int r = row0 + ai * 128 + m * 16; const float s = rs[ai][m];
#pragma unroll
                for (int bj = 0; bj < 2; ++bj) { f32x4 a = acc[ai][bj][m][0] * s, b = acc[ai][bj][m][1] * s;
                    a = gelu4(a); b = gelu4(b);
                    st_wt(U + (size_t)r * D + 256 * t + 128 * bj + pc, pack8(a, b)); } }
        } else if (t < 8) {
#pragma unroll
            EPI_ROWS(ai, m) { const int r = row0 + ai * 128 + m * 16; const float s = rs[ai][m]; float s1 = 0.f, s2 = 0.f;
#pragma unroll
                for (int bj = 0; bj < 2; ++bj) { f32x4 a = acc[ai][bj][m][0] * s, b = acc[ai][bj][m][1] * s;
                    a = gelu4(a); b = gelu4(b); s1 += sum4(a) + sum4(b); s2 += sum4(a * a) + sum4(b * b);
                    st_wt(Vg + (size_t)r * D + 256 * (t - 4) + 128 * bj + pc, pack8(a, b)); }
                s1 = qsum(s1); s2 = qsum(s2);
                if (fq == 0) *(f32x2*)(vstp + ((size_t)r * 16 + (t - 4) * 4 + wc) * 2) = (f32x2){s1, s2}; }
        } else if (t < 11) {
            bf16_t* O = (t < 10) ? CQ : CKV; const int ldo = (t < 10) ? QL : KVL; const int cb = (t < 10) ? 256 * (t - 8) : 0;
            float* pp = (t < 10) ? cqp : ckvp; const int np = (t < 10) ? 8 : 4; const int pi = (t < 10) ? (t - 8) * 4 + wc : wc;
#pragma unroll
            EPI_ROWS(ai, m) { const int r = row0 + ai * 128 + m * 16; const float s = rs[ai][m]; float s2 = 0.f;
#pragma unroll
                for (int bj = 0; bj < 2; ++bj) { f32x4 a = acc[ai][bj][m][0] * s, b = acc[ai][bj][m][1] * s;
#pragma unroll
                    for (int i = 0; i < 4; ++i) s2 += a[i] * a[i] + b[i] * b[i];
                    st_wt(O + (size_t)r * ldo + cb + 128 * bj + pc, pack8(a, b)); }
                s2 = qsum(s2);
                if (fq == 0) pp[(size_t)r * np + pi] = s2; }
        } else if (t == 11) {
            if (wc == 0) {
                const f32x4 g0 = *(const f32x4*)(gk + 64 + 4 * fq), g1 = *(const f32x4*)(gk + 80 + 4 * fq);
#pragma unroll
              for (int ai = 0; ai < 2; ++ai) { f32x4 cc_[4], ss_[4];
#pragma unroll
                for (int m = 0; m < 4; ++m) { const int pos = (row0 + ai * 128 + m * 16) & (SEQ - 1); cc_[m] = *(const f32x4*)(cosT + pos * 16 + 4 * fq); ss_[m] = *(const f32x4*)(sinT + pos * 16 + 4 * fq); }
                __builtin_amdgcn_sched_barrier(0);
#pragma unroll
                for (int m = 0; m < 4; ++m) { const int r = row0 + ai * 128 + m * 16; const float s = rs[ai][m];
                    const f32x4 a0 = acc[ai][0][m][0] * s, a1 = acc[ai][0][m][1] * s;
                    float s2 = sum4(a0 * a0) + sum4(a1 * a1); s2 = qsum(s2);
                    const f32x4 c = cc_[m], sn = ss_[m];
                    const f32x4 x0 = a0 * g0, x1 = a1 * g1;
                    *(f32x4*)(KR + (size_t)r * 32 + 4 * fq) = x0 * c - x1 * sn;
                    *(f32x4*)(KR + (size_t)r * 32 + 16 + 4 * fq) = x1 * c + x0 * sn;
                    if (fq == 0) krss[r] = s2; } }
            }
        } else {
#pragma unroll
            EPI_ROWS(ai, m) { const int r = row0 + ai * 128 + m * 16; const float s = rs[ai][m];
#pragma unroll
                for (int bj = 0; bj < 2; ++bj) { f32x4 a = acc[ai][bj][m][0] * s, b = acc[ai][bj][m][1] * s;
                    a = sigm4(a); b = sigm4(b);
                    st_wt(G + (size_t)r * 2048 + 256 * (t - 12) + 128 * bj + pc, pack8(a, b)); } }
        }
    }
};


struct EpiRaw {
    static constexpr bool AFTER_DRAIN = false;
    bf16_t* O; int ldc;
    __device__ __forceinline__ void operator()(f32x4 (&acc)[2][2][4][2], const Unit& u, int wr, int wc, int fr, int fq, LAS unsigned char*) const {
        int row0 = u.pm * 256 + wr * 64 + fr; asm volatile("" : "+v"(row0)); const int pc = 32 * wc + 8 * fq;
#pragma unroll
        EPI_ROWS(ai, m) { const int r = row0 + ai * 128 + m * 16;
#pragma unroll
            for (int bj = 0; bj < 2; ++bj) *(u32x4*)(O + (size_t)r * ldc + 256 * u.pn + 128 * bj + pc) = pack8(acc[ai][bj][m][0], acc[ai][bj][m][1]); }
    }
};

struct EpiQ {
    static constexpr bool AFTER_DRAIN = false;
    const float* cqp; const float* gq; const float *cosT, *sinT; bf16_t* Q;
    __device__ __forceinline__ void operator()(f32x4 (&acc)[2][2][4][2], const Unit& u, int wr, int wc, int fr, int fq, LAS unsigned char* lds) const {
        LAS float* P = (LAS float*)(lds + XCH_OFF); asm volatile("" : "+v"(fq));
        int row0 = u.pm * 256 + wr * 64 + fr; asm volatile("" : "+v"(row0)); const int head = 2 * u.pn + (wc >> 1), half = wc & 1;
        float ps[2][4], rsq_[2][4];
#pragma unroll
        for (int am = 0; am < 4; ++am) { const int ai = am >> 1; f32x4 c0_[2], c1_[2];
#pragma unroll
            for (int h_ = 0; h_ < 2; ++h_) { const int r = row0 + ai * 128 + (2 * (am & 1) + h_) * 16; c0_[h_] = *(const f32x4*)(cqp + (size_t)r * 8); c1_[h_] = *(const f32x4*)(cqp + (size_t)r * 8 + 4); }
            __builtin_amdgcn_sched_barrier(0);
#pragma unroll
            for (int h_ = 0; h_ < 2; ++h_) rsq_[ai][2 * (am & 1) + h_] = frsq((sum4(c0_[h_]) + sum4(c1_[h_])) * (1.0f / QL) + EPS); }
#pragma unroll
        EPI_ROWS(ai, m) {
            const float rs = rsq_[ai][m];
            f32x4 a = acc[ai][0][m][0] * rs, b = acc[ai][0][m][1] * rs; acc[ai][0][m][0] = a; acc[ai][0][m][1] = b;
            float s = sum4(a * a) + sum4(b * b);
            if (half == 0) { f32x4 c = acc[ai][1][m][0] * rs, d = acc[ai][1][m][1] * rs; acc[ai][1][m][0] = c; acc[ai][1][m][1] = d; s += sum4(c * c) + sum4(d * d); }
            s = qsum(s); ps[ai][m] = s;
            if (fq == 0) P[(ai * 128 + wr * 64 + m * 16 + fr) * 4 + wc] = s; }
        LDS_WAIT(); RAW_BAR();
        const f32x4 gn0 = *(const f32x4*)(gq + 32 * half + 8 * fq), gn1 = *(const f32x4*)(gq + 32 * half + 8 * fq + 4);
        const f32x4 gr0 = *(const f32x4*)(gq + 64 + 4 * fq), gr1 = *(const f32x4*)(gq + 80 + 4 * fq);
#pragma unroll
        for (int am = 0; am < 4; ++am) { const int ai = am >> 1; f32x4 cc_[2], ss_[2];
            if (half == 0) {
#pragma unroll
                for (int h_ = 0; h_ < 2; ++h_) { const int pos = (row0 + ai * 128 + (2 * (am & 1) + h_) * 16) & (SEQ - 1); cc_[h_] = *(const f32x4*)(cosT + pos * 16 + 4 * fq); ss_[h_] = *(const f32x4*)(sinT + pos * 16 + 4 * fq); }
            }
            __builtin_amdgcn_sched_barrier(0);
#pragma unroll
          for (int h_ = 0; h_ < 2; ++h_) { const int m = 2 * (am & 1) + h_; const int r = row0 + ai * 128 + m * 16; const int rl = ai * 128 + wr * 64 + m * 16 + fr;
            const float oth = P[rl * 4 + (wc ^ 1)];
            const float rstd = frsq((ps[ai][m] + oth) * (1.0f / DQK) + EPS) * C2;
            bf16_t* qrow = Q + (size_t)r * (NH * DQK) + head * DQK;
            *(u32x4*)(qrow + 32 * half + 8 * fq) = pack8(acc[ai][0][m][0] * gn0 * rstd, acc[ai][0][m][1] * gn1 * rstd);
            if (half == 0) {
                const f32x4 c = cc_[h_], sn = ss_[h_];
                const f32x4 x0 = acc[ai][1][m][0] * gr0, x1 = acc[ai][1][m][1] * gr1;
                const f32x4 o1 = (x0 * c - x1 * sn) * rstd, o2 = (x1 * c + x0 * sn) * rstd;
                *(u32x2*)(qrow + 64 + 4 * fq) = (u32x2){cvt_pk_bf16(o1.x, o1.y), cvt_pk_bf16(o1.z, o1.w)};
                *(u32x2*)(qrow + 80 + 4 * fq) = (u32x2){cvt_pk_bf16(o2.x, o2.y), cvt_pk_bf16(o2.z, o2.w)}; } } }
    }
};

struct EpiKV {
    static constexpr bool AFTER_DRAIN = false;
    const float* ckvp; const float* krss; const float* KR; const float* gk; bf16_t *Kt, *Vt;
    __device__ __forceinline__ void operator()(f32x4 (&acc)[2][2][4][2], const Unit& u, int wr, int wc, int fr, int fq, LAS unsigned char*) const {
        int row0 = u.pm * 256 + wr * 64 + fr; asm volatile("" : "+v"(row0)); const int head = 2 * u.pn + (wc >> 1), isv = wc & 1;
        asm volatile("" : "+v"(fq));
        float rsv[2][4], kss[2][4];
#pragma unroll
        for (int ai = 0; ai < 2; ++ai) { f32x4 xs_[4];
#pragma unroll
            for (int m = 0; m < 4; ++m) { const int r = row0 + ai * 128 + m * 16; xs_[m] = *(const f32x4*)(ckvp + (size_t)r * 4); kss[ai][m] = isv ? 0.f : krss[r]; }
            __builtin_amdgcn_sched_barrier(0);
#pragma unroll
            for (int m = 0; m < 4; ++m) rsv[ai][m] = frsq(sum4(xs_[m]) * (1.0f / KVL) + EPS);
            __builtin_amdgcn_sched_barrier(0); }
        f32x4 g[2][2];
#pragma unroll
        for (int bj = 0; bj < 2; ++bj) { g[bj][0] = *(const f32x4*)(gk + 32 * bj + 8 * fq); g[bj][1] = *(const f32x4*)(gk + 32 * bj + 8 * fq + 4); }
#pragma unroll
        EPI_ROWS(ai, m) { const int r = row0 + ai * 128 + m * 16; const int b = r >> 11, sq = r & (SEQ - 1), tile = sq >> 6, key = sq & 63;
            const float rs = rsv[ai][m];
            const size_t bht = (size_t)(b * NH + head) * 32 + tile;
            if (isv) {
#pragma unroll
                for (int bj = 0; bj < 2; ++bj) st_wt(Vt + (bht * 2 + bj) * 2048 + key * 32 + 8 * fq, pack8(acc[ai][bj][m][0] * rs, acc[ai][bj][m][1] * rs));
            } else {
                f32x4 v[2][2]; float s_ = 0.f;
#pragma unroll
                for (int bj = 0; bj < 2; ++bj)
#pragma unroll
                    for (int n = 0; n < 2; ++n) { v[bj][n] = acc[ai][bj][m][n] * rs; s_ += sum4(v[bj][n] * v[bj][n]); }
                s_ = qsum(s_) + kss[ai][m];
                const float rstd = frsq(s_ * (1.0f / DQK) + EPS);
#pragma unroll
                for (int bj = 0; bj < 2; ++bj) st_wt(Kt + (bht * 12 + 4 * bj + fq) * 512 + key * 8, pack8(v[bj][0] * g[bj][0] * rstd, v[bj][1] * g[bj][1] * rstd));
                const f32x4 k0 = *(const f32x4*)(KR + (size_t)r * 32 + 8 * fq), k1 = *(const f32x4*)(KR + (size_t)r * 32 + 8 * fq + 4);
                st_wt(Kt + (bht * 12 + 8 + fq) * 512 + key * 8, pack8(k0 * rstd, k1 * rstd));
            } }
    }
};

struct EpiProjF {
    static constexpr bool AFTER_DRAIN = false;
    const bf16_t* G; bf16_t* MG;
    __device__ __forceinline__ void mid(f32x4 (&acc)[2][2][4][2], const Unit& u, int wr, int wc, int fr, int fq) const {
        int row0 = u.pm * 256 + wr * 64 + fr; asm volatile("" : "+v"(row0)); const int col0 = u.pn * 256 + 32 * wc + 8 * fq;
#pragma unroll
        for (int ai = 0; ai < 2; ++ai) { u32x4 ga_[4][2], gb_[4][2];
#pragma unroll
            for (int m = 0; m < 4; ++m) { const int r = row0 + ai * 128 + m * 16;
#pragma unroll
                for (int bj = 0; bj < 2; ++bj) { const int c = col0 + 128 * bj; ga_[m][bj] = *(const u32x4*)(G + (size_t)r * 2048 + c); gb_[m][bj] = *(const u32x4*)(G + (size_t)r * 2048 + 1024 + c); } }
            __builtin_amdgcn_sched_barrier(0);
#pragma unroll
            for (int m = 0; m < 4; ++m)
#pragma unroll
                for (int bj = 0; bj < 2; ++bj) { const u32x4 ga = ga_[m][bj], gb = gb_[m][bj];
                    const f32x4 r0 = {bf_lo(ga.x) * frcp(bf_lo(gb.x)), bf_hi(ga.x) * frcp(bf_hi(gb.x)), bf_lo(ga.y) * frcp(bf_lo(gb.y)), bf_hi(ga.y) * frcp(bf_hi(gb.y))};
                    const f32x4 r1 = {bf_lo(ga.z) * frcp(bf_lo(gb.z)), bf_hi(ga.z) * frcp(bf_hi(gb.z)), bf_lo(ga.w) * frcp(bf_lo(gb.w)), bf_hi(ga.w) * frcp(bf_hi(gb.w))};
                    acc[ai][bj][m][0] = acc[ai][bj][m][0] * r0; acc[ai][bj][m][1] = acc[ai][bj][m][1] * r1; }
            __builtin_amdgcn_sched_barrier(0); }
    }
    __device__ __forceinline__ void operator()(f32x4 (&acc)[2][2][4][2], const Unit& u, int wr, int wc, int fr, int fq, LAS unsigned char*) const {
        int row0 = u.pm * 256 + wr * 64 + fr; asm volatile("" : "+v"(row0)); const int col0 = u.pn * 256 + 32 * wc + 8 * fq;
        u32x4 gb_[2][4][2];
#pragma unroll
        EPI_ROWS(ai, m) { const int r = row0 + ai * 128 + m * 16;
#pragma unroll
            for (int bj = 0; bj < 2; ++bj) gb_[ai][m][bj] = *(const u32x4*)(G + (size_t)r * 2048 + 1024 + col0 + 128 * bj); }
        __builtin_amdgcn_sched_barrier(0);
#pragma unroll
        EPI_ROWS(ai, m) { const int r = row0 + ai * 128 + m * 16;
#pragma unroll
            for (int bj = 0; bj < 2; ++bj) { const int c = col0 + 128 * bj; const u32x4 gb = gb_[ai][m][bj];
                const f32x4 g0 = {bf_lo(gb.x), bf_hi(gb.x), bf_lo(gb.y), bf_hi(gb.y)}, g1 = {bf_lo(gb.z), bf_hi(gb.z), bf_lo(gb.w), bf_hi(gb.w)};
                *(u32x4*)(MG + (size_t)r * D + c) = pack8(acc[ai][bj][m][0] * g0, acc[ai][bj][m][1] * g1); } }
    }
};

struct EpiRes {
    static constexpr bool AFTER_DRAIN = true;
    const float* res; float* out; bf16_t* XB; float* xssp; unsigned char* XB8;
    __device__ __forceinline__ void operator()(f32x4 (&)[2][2][4][2], const Unit&, int, int, int, int, LAS unsigned char*) const {}
    __device__ __forceinline__ void fused(f32x4 (&acc)[2][2][4][2], const Unit& u, int wr, int wc, int fr, int fq, LAS unsigned char* lds, int wid, int lane) const {
        LAS float* P = (LAS float*)lds;
        int row0 = u.pm * 256 + wr * 64 + fr; asm volatile("" : "+v"(row0)); const int col0 = u.pn * 256 + 32 * wc + 8 * fq;
#if RES_BF16
        u32x4 xr_[2][4][2];
#pragma unroll
        EPI_ROWS(ai, m) { const int r = row0 + ai * 128 + m * 16;
#pragma unroll
            for (int bj = 0; bj < 2; ++bj) xr_[ai][m][bj] = *(const u32x4*)(XB + (size_t)r * D + col0 + 128 * bj); }
        __builtin_amdgcn_sched_barrier(0);
#pragma unroll
        EPI_ROWS(ai, m) { const int r = row0 + ai * 128 + m * 16; float s = 0.f;
#pragma unroll
            for (int bj = 0; bj < 2; ++bj) { const size_t o = (size_t)r * D + col0 + 128 * bj; const u32x4 xr = xr_[ai][m][bj];
                const f32x4 a = (f32x4){bf_lo(xr.x), bf_hi(xr.x), bf_lo(xr.y), bf_hi(xr.y)} + acc[ai][bj][m][0], b = (f32x4){bf_lo(xr.z), bf_hi(xr.z), bf_lo(xr.w), bf_hi(xr.w)} + acc[ai][bj][m][1];
                *(u32x4*)(XB + o) = pack8(a, b); if (XB8) *(u32x2*)(XB8 + o) = pack8_f8(a, b);
                s += sum4(a * a) + sum4(b * b); }
            s = qsum(s);
            if (fq == 0) P[(ai * 128 + wr * 64 + m * 16 + fr) * 4 + wc] = s; }
#else
#pragma unroll
        EPI_ROWS(ai, m) { const int r = row0 + ai * 128 + m * 16; float s = 0.f;
#pragma unroll
            for (int bj = 0; bj < 2; ++bj) { const size_t o = (size_t)r * D + col0 + 128 * bj;
#if RES_BF16
                const u32x4 xr = *(const u32x4*)(XB + o);
                const f32x4 a = (f32x4){bf_lo(xr.x), bf_hi(xr.x), bf_lo(xr.y), bf_hi(xr.y)} + acc[ai][bj][m][0], b = (f32x4){bf_lo(xr.z), bf_hi(xr.z), bf_lo(xr.w), bf_hi(xr.w)} + acc[ai][bj][m][1];
#else
                const f32x4 a = ld_nt(res + o) + acc[ai][bj][m][0], b = ld_nt(res + o + 4) + acc[ai][bj][m][1];
                *(f32x4*)(out + o) = a; *(f32x4*)(out + o + 4) = b;
#endif
                *(u32x4*)(XB + o) = pack8(a, b); if (XB8) *(u32x2*)(XB8 + o) = pack8_f8(a, b);
                s += sum4(a * a) + sum4(b * b); }
            s = qsum(s);
            if (fq == 0) P[(ai * 128 + wr * 64 + m * 16 + fr) * 4 + wc] = s; }
#endif
        LDS_WAIT(); RAW_BAR();
        const int tid = wid * 64 + lane;
        if (tid < 256) { const f32x4 v = *(const LAS f32x4*)(P + tid * 4); xssp[(size_t)(u.pm * 256 + tid) * 4 + u.pn] = sum4(v); }
    }
};

template <bool MOE> struct EpiGU {
    static constexpr bool AFTER_DRAIN = false;
    const float* xssp; bf16_t* ACT; const float* idxr;
    __device__ __forceinline__ void operator()(f32x4 (&acc)[2][2][4][2], const Unit& u, int wr, int wc, int fr, int fq, LAS unsigned char*) const {
        int row0 = u.pm * 256 + wr * 64 + fr; asm volatile("" : "+v"(row0)); const int col0 = u.pn * 128 + 32 * wc + 8 * fq;
        const int e = u.e, cn = u.cn; int p0 = u.p0 + wr * 64 + fr; asm volatile("" : "+v"(p0));
#if MOE_FP8 && ACT8_WIDE
        if (MOE) {
            float rw_[2][4];
#pragma unroll
            EPI_ROWS(ai, m) { const int pos = p0 + ai * 128 + m * 16; rw_[ai][m] = idxr[e * M + (pos < cn ? pos : cn - 1)]; }
            __builtin_amdgcn_sched_barrier(0);
#pragma unroll
            for (int ai = 0; ai < 2; ++ai)
#pragma unroll
                for (int mp = 0; mp < 2; ++mp) { u32x2 pk[2];
#pragma unroll
                    for (int h = 0; h < 2; ++h) { const int m = 2 * mp + h; const int pos = p0 + ai * 128 + m * 16; const float rs = pos < cn ? rw_[ai][m] : (1.0f / W8_SCALE);
                        f32x4 a = acc[ai][0][m][0] * rs, b = acc[ai][0][m][1] * rs; const f32x4 c = acc[ai][1][m][0] * rs, d = acc[ai][1][m][1] * rs;
                        a = a * sigm4(a) * c; b = b * sigm4(b) * d; pk[h] = pack8_f8(a, b); }
                    const auto s0 = __builtin_amdgcn_permlane16_swap(pk[0].x, pk[1].x, false, false), s1 = __builtin_amdgcn_permlane16_swap(pk[0].y, pk[1].y, false, false);
                    const int r = row0 + ai * 128 + (2 * mp + (fq & 1)) * 16;
                    *(u32x4*)((unsigned char*)ACT + (size_t)r * FF + col0 - 8 * (fq & 1)) = (u32x4){s0[0], s1[0], s0[1], s1[1]}; }
            return; }
#endif
        float rsv[2][4]; { f32x4 xs_[2][4];
#pragma unroll
        EPI_ROWS(ai, m) { const int r = row0 + ai * 128 + m * 16;
            if (MOE) { const int pos = p0 + ai * 128 + m * 16; xs_[ai][m] = (f32x4){idxr[e * M + (pos < cn ? pos : cn - 1)], 0.f, 0.f, 0.f}; }
            else xs_[ai][m] = *(const f32x4*)(xssp + (size_t)r * 4); }
        __builtin_amdgcn_sched_barrier(0);
#pragma unroll
        EPI_ROWS(ai, m) { if (MOE) { const int pos = p0 + ai * 128 + m * 16; rsv[ai][m] = pos < cn ? xs_[ai][m].x : (1.0f / W8_SCALE); } else rsv[ai][m] = frsq(sum4(xs_[ai][m]) * (1.0f / D) + EPS); } }
#pragma unroll
        EPI_ROWS(ai, m) { const int r = row0 + ai * 128 + m * 16; const float rs = rsv[ai][m];
            f32x4 a = acc[ai][0][m][0] * rs, b = acc[ai][0][m][1] * rs; const f32x4 c = acc[ai][1][m][0] * rs, d = acc[ai][1][m][1] * rs;
            a = a * sigm4(a) * c; b = b * sigm4(b) * d;
            if (MOE && MOE_FP8) *(u32x2*)((unsigned char*)ACT + (size_t)r * FF + col0) = pack8_f8(a, b);
            else st_wt(ACT + (size_t)r * FF + col0, pack8(a, b)); }
    }
};

struct EpiMoeDn {
    static constexpr bool AFTER_DRAIN = false;
    bf16_t* Y; const float* idxw;
    __device__ __forceinline__ void operator()(f32x4 (&acc)[2][2][4][2], const Unit& u, int wr, int wc, int fr, int fq, LAS unsigned char*) const {
        const int e = u.e; int p0 = u.p0 + wr * 64 + fr; asm volatile("" : "+v"(p0)); const int cn = u.cn;
        const int col0 = (u.pn & 3) * 256 + 32 * wc + 8 * fq; const int row0 = u.pm * 256 + wr * 64 + fr;
        bf16_t* Yk = Y + (size_t)(u.pn >> 2) * SLOTS * D;
        float wv[2][4];
#pragma unroll
        EPI_ROWS(ai, m) { const int pos = p0 + ai * 128 + m * 16; wv[ai][m] = idxw[e * M + (pos < cn ? pos : cn - 1)]; }
        __builtin_amdgcn_sched_barrier(0);
#pragma unroll
        EPI_ROWS(ai, m) { const int pos = p0 + ai * 128 + m * 16;
            if (pos < cn) { const float w = wv[ai][m] * (1.0f / W8_SCALE); bf16_t* o = Yk + (size_t)(row0 + ai * 128 + m * 16) * D + col0;
#pragma unroll
                for (int bj = 0; bj < 2; ++bj) *(u32x4*)(o + 128 * bj) = pack8(acc[ai][bj][m][0] * w, acc[ai][bj][m][1] * w); } }
    }
};

#define XB_TMO      128
#define XB_XCNT(j)  (256  + 64 * (j))
#define XB_XSUB(j)  (1280 + 64 * (j))
#define XB_XGEN(j)  (2304 + 64 * (j))
#define XB_TOP      3328
#define XB_TOPGEN   3392
#define XCD_BAR_WORDS 3456
#define XB_SPIN_CAP (1u << 18)
__device__ __forceinline__ unsigned xb_ld(unsigned* p)              { return __hip_atomic_load(p, __ATOMIC_RELAXED, __HIP_MEMORY_SCOPE_AGENT); }
__device__ __forceinline__ unsigned xb_add(unsigned* p, unsigned v) { return __hip_atomic_fetch_add(p, v, __ATOMIC_RELAXED, __HIP_MEMORY_SCOPE_AGENT); }
__device__ __forceinline__ unsigned xb_xcc_id() { return (unsigned)__builtin_amdgcn_s_getreg((3 << 11) | 20) & 0xFu; }
#define XB_SPIN(cond, bar) do { unsigned _sp = 0; while (cond) { __builtin_amdgcn_s_sleep(1); \
    if ((++_sp & 255u) == 0u) { if (xb_ld(&(bar)[XB_TMO])) break; if (_sp > XB_SPIN_CAP) { atomicAdd(&(bar)[XB_TMO], 1u); break; } } } } while (0)
struct XcdBarrier { unsigned* bar; unsigned x; volatile LAS unsigned* st; };
__device__ __forceinline__ XcdBarrier xcd_barrier_post(unsigned* bar, volatile LAS unsigned* st) {
    XcdBarrier b; b.bar = bar; b.x = xb_xcc_id(); b.st = st;
    if (threadIdx.x == 0) (void)xb_add(&bar[XB_XCNT(b.x)], 1u);
    return b;
}
__device__ __forceinline__ void xcd_barrier_complete(unsigned* bar, unsigned x, unsigned& nloc, unsigned& nx) {
    const unsigned G = gridDim.x * gridDim.y * gridDim.z;
    unsigned sum, cnt, mine, sp = 0u;
    for (;;) {
        sum = 0u; cnt = 0u; mine = 0u;
#pragma unroll
        for (unsigned j = 0; j < 16; ++j) { const unsigned c = xb_ld(&bar[XB_XCNT(j)]); sum += c; cnt += (c > 0u) ? 1u : 0u; mine = (j == x) ? c : mine; }
        if (sum == G) break;
        __builtin_amdgcn_s_sleep(1);
        if ((++sp & 255u) == 0u) { if (xb_ld(&bar[XB_TMO])) break; if (sp > XB_SPIN_CAP) { atomicAdd(&bar[XB_TMO], 1u); break; } }
    }
    nloc = mine > 0u ? mine : 1u; nx = cnt > 0u ? cnt : 1u;
}
__device__ __forceinline__ void xcd_barrier(const XcdBarrier& b) {
    asm volatile("s_waitcnt vmcnt(0)" ::: "memory");
    __syncthreads();
    if (threadIdx.x == 0) {
        unsigned* bar = b.bar;
        __builtin_amdgcn_s_waitcnt(0);
        unsigned nloc = b.st[0], nx = b.st[1];
        if (nloc == 0u) { xcd_barrier_complete(bar, b.x, nloc, nx); b.st[0] = nloc; b.st[1] = nx; }
        const unsigned old = xb_add(&bar[XB_XSUB(b.x)], 1u);
        const unsigned gen = old / nloc;
        if (old + 1u == (gen + 1u) * nloc) {
            __builtin_amdgcn_fence(__ATOMIC_RELEASE, "agent");
            asm volatile("s_waitcnt vmcnt(0)" ::: "memory");
            const unsigned og = xb_add(&bar[XB_TOP], 1u);
            const unsigned tg = og / nx;
            if (og + 1u == (tg + 1u) * nx) xb_add(&bar[XB_TOPGEN], 1u);
            else XB_SPIN(xb_ld(&bar[XB_TOPGEN]) == tg, bar);
            __builtin_amdgcn_fence(__ATOMIC_ACQUIRE, "agent");
            xb_add(&bar[XB_XGEN(b.x)], 1u);
            asm volatile("s_waitcnt vmcnt(0)" ::: "memory");
        } else {
            XB_SPIN(xb_ld(&bar[XB_XGEN(b.x)]) == gen, bar);
            __builtin_amdgcn_fence(__ATOMIC_ACQUIRE, "agent");
            asm volatile("s_waitcnt vmcnt(0)" ::: "memory");
        }
    }
    __syncthreads();
}

#ifndef ATT_SUM_THR
#define ATT_SUM_THR 1.0e9f
#endif
namespace att {
constexpr int KSLOT = 12288, VSLOT = 8192, SLOT = KSLOT + VSLOT, NSLOT = 4, WSF_OFF = NSLOT * SLOT, OST_OFF = WSF_OFF + 2048, LDS_NEED = OST_OFF + 8 * 4096;
static_assert(LDS_NEED <= RING_BYTES, "attention LDS");
__device__ __forceinline__ void glds16(const void* gsrc, unsigned lds_dst) { unsigned keep;
    asm volatile("s_mov_b32 %0, m0\n\ts_mov_b32 m0, %2\n\ts_nop 0\n\tglobal_load_lds_dwordx4 %1, off\n\ts_mov_b32 m0, %0" : "=&s"(keep) : "v"(gsrc), "s"(lds_dst) : "memory"); }
typedef short v4i16_t __attribute__((ext_vector_type(4)));
typedef LAS const char* lds_cptr;
__device__ __forceinline__ s16x4 vtr(lds_cptr p) { return __builtin_bit_cast(s16x4, __builtin_amdgcn_ds_read_tr16_b64_v4i16((LAS v4i16_t*)p)); }

__device__ __forceinline__ void attn_unit(int b, int h, int qb, const bf16_t* Q, const bf16_t* __restrict__ Kt, const bf16_t* __restrict__ Vt, bf16_t* O, char* shm) {
    int tid = threadIdx.x; asm volatile("" : "+v"(tid));
    const int lane = tid & 63, r32 = lane & 31, hi = lane >> 5; const int wid = __builtin_amdgcn_readfirstlane(tid >> 6);
    const int q0 = qb * 256; const int NT = 4 * (qb + 1);
    const size_t rowbase = (size_t)b * SEQ;
    const bf16_t* Kbh = Kt + (size_t)(b * NH + h) * 32 * 6144;
    const bf16_t* Vbh = Vt + (size_t)(b * NH + h) * 32 * 4096;
    const unsigned lds0 = (unsigned)(uintptr_t)shm;
    const lds_cptr shm3 = (lds_cptr)shm;
    LAS float* wsf = (LAS float*)(shm3 + WSF_OFF) + wid * 64;
#define ATT_DMA(t, sl) do { const bf16_t* kt_ = Kbh + (size_t)(t) * 6144; const bf16_t* vt_ = Vbh + (size_t)(t) * 4096; const unsigned sb_ = lds0 + (sl) * SLOT; \
        glds16(kt_ + wid * 512 + lane * 8, (unsigned)__builtin_amdgcn_readfirstlane(sb_ + wid * 1024)); \
        if (wid < 4) { glds16(kt_ + (wid + 8) * 512 + lane * 8, (unsigned)__builtin_amdgcn_readfirstlane(sb_ + (wid + 8) * 1024)); \
                       glds16(vt_ + (wid + 4) * 512 + lane * 8, (unsigned)__builtin_amdgcn_readfirstlane(sb_ + KSLOT + (wid + 4) * 1024)); } \
        else { glds16(vt_ + (wid - 4) * 512 + lane * 8, (unsigned)__builtin_amdgcn_readfirstlane(sb_ + KSLOT + (wid - 4) * 1024)); } } while (0)
    ATT_DMA(0, 0); ATT_DMA(1, 1);
    bf16x8 qr[6];
    { const bf16_t* Qw = Q + (rowbase + q0 + wid * 32 + r32) * (size_t)(NH * DQK) + h * DQK + hi * 8;
#pragma unroll
      for (int d0 = 0; d0 < 6; ++d0) qr[d0] = *(const bf16x8*)(Qw + d0 * 16); }
    constexpr float SUM_THR = ATT_SUM_THR;
    float mhat = 0.f, l_reg = 0.f; f32x16 o[2]; o[0] = f32x16{}; o[1] = f32x16{}; f32x16 negm = f32x16{};
    const int qrel = wid * 32 + r32;
    const int vpo = ((lane >> 4) & 1) * 32 + (lane & 3) * 8 + (4 * hi + ((lane & 15) >> 2)) * 64;
    asm volatile("s_waitcnt vmcnt(0)" ::: "memory");
    const int grp = wid >> 2;
    u32x4 pw[4]; bool pend = false;
    int sl = 0, slp = 0;
#define ATT_PV(PW, slot) do { const lds_cptr vp_ = shm3 + (slot) * SLOT + KSLOT + vpo; \
        _Pragma("unroll") for (int d0 = 0; d0 < 2; ++d0) _Pragma("unroll") for (int ks = 0; ks < 4; ks += 2) { \
            const s16x4 lo = vtr(vp_ + d0 * 4096 + ks * 1024), hh = vtr(vp_ + d0 * 4096 + ks * 1024 + 512); \
            const s16x4 lo2 = vtr(vp_ + d0 * 4096 + (ks + 1) * 1024), hh2 = vtr(vp_ + d0 * 4096 + (ks + 1) * 1024 + 512); \
            __builtin_amdgcn_sched_barrier(0); \
            const bf16x8 vf = (bf16x8){lo[0], lo[1], lo[2], lo[3], hh[0], hh[1], hh[2], hh[3]}, vf2 = (bf16x8){lo2[0], lo2[1], lo2[2], lo2[3], hh2[0], hh2[1], hh2[2], hh2[3]}; \
            o[d0] = __builtin_amdgcn_mfma_f32_32x32x16_bf16(__builtin_bit_cast(bf16x8, PW[ks]), vf, o[d0], 0, 0, 0); \
            o[d0] = __builtin_amdgcn_mfma_f32_32x32x16_bf16(__builtin_bit_cast(bf16x8, PW[ks + 1]), vf2, o[d0], 0, 0, 0); } } while (0)
    for (int t = 0; t < NT; ++t) {
        if (t > 0) { if (t + 1 < NT) { if (wid < 4) asm volatile("s_waitcnt vmcnt(3)" ::: "memory"); else asm volatile("s_waitcnt vmcnt(2)" ::: "memory"); } else asm volatile("s_waitcnt vmcnt(0)" ::: "memory"); }
        asm volatile("s_waitcnt lgkmcnt(0)\n\ts_barrier" ::: "memory");
        if (t + 2 < NT) { const int s2 = (sl + 2) & 3; ATT_DMA(t + 2, s2); }
        const int slc = sl; sl = (sl + 1) & 3;
        const lds_cptr kp = shm3 + slc * SLOT + hi * 1024 + r32 * 16;
#define ATT_KLD(G_, d0_) const bf16x8 G_##0 = *(const LAS bf16x8*)(kp + (d0_) * 2048), G_##1 = *(const LAS bf16x8*)(kp + (d0_) * 2048 + 512), \
                                      G_##2 = *(const LAS bf16x8*)(kp + ((d0_) + 1) * 2048), G_##3 = *(const LAS bf16x8*)(kp + ((d0_) + 1) * 2048 + 512)
#define ATT_KMM(G_, d0_) do { p0 = __builtin_amdgcn_mfma_f32_32x32x16_bf16(G_##0, qr[d0_], p0, 0, 0, 0); p1 = __builtin_amdgcn_mfma_f32_32x32x16_bf16(G_##1, qr[d0_], p1, 0, 0, 0); \
                              p0 = __builtin_amdgcn_mfma_f32_32x32x16_bf16(G_##2, qr[(d0_) + 1], p0, 0, 0, 0); p1 = __builtin_amdgcn_mfma_f32_32x32x16_bf16(G_##3, qr[(d0_) + 1], p1, 0, 0, 0); } while (0)
        ATT_KLD(ka, 0);
        __builtin_amdgcn_sched_barrier(0);
        if (grp && pend) { ATT_PV(pw, slp); pend = false; }
        slp = slc;
        const int jb = t - (NT - 4);
        if (jb >= 0 && 64 * jb > 32 * wid + 31) continue;
        f32x16 p0 = negm, p1 = negm;
        {
            ATT_KLD(kb, 2);
            __builtin_amdgcn_sched_barrier(0);
            ATT_KMM(ka, 0);
            __builtin_amdgcn_sched_barrier(0);
            ATT_KLD(kc, 4);
            __builtin_amdgcn_sched_barrier(0);
            ATT_KMM(kb, 2);
            __builtin_amdgcn_sched_barrier(0);
            ATT_KMM(kc, 4);
#undef ATT_KLD
#undef ATT_KMM
        }
        if (jb >= 0 && 64 * jb + 63 > 32 * wid) { const int kb = 64 * jb + 4 * hi;
#pragma unroll
            for (int r = 0; r < 16; ++r) { const int kv = kb + (r & 3) + 8 * (r >> 2); if (kv > qrel) p0[r] = -INFINITY; if (kv + 32 > qrel) p1[r] = -INFINITY; } }
        f32x2 sa2 = {0.f, 0.f}, sb2 = {0.f, 0.f};
#pragma unroll
        for (int r = 0; r < 16; r += 2) { p0[r] = fexp2(p0[r]); p0[r + 1] = fexp2(p0[r + 1]); p1[r] = fexp2(p1[r]); p1[r + 1] = fexp2(p1[r + 1]);
            sa2 += (f32x2){p0[r], p0[r + 1]}; sb2 += (f32x2){p1[r], p1[r + 1]}; }
        sa2 += sb2; float sacc = sa2.x + sa2.y;
        if (__any(sacc > SUM_THR)) {
            const float s2 = xmax32(sacc);
            const float dl = s2 > SUM_THR ? floorf(__builtin_amdgcn_logf(s2)) : 0.f; mhat += dl;
            const float f = fexp2(-dl); l_reg *= f; sacc *= f;
#pragma unroll
            for (int r = 0; r < 16; ++r) { p0[r] *= f; p1[r] *= f; negm[r] = -mhat; }
            if (hi == 0) wsf[r32] = f;
            LDS_WAIT();
#pragma unroll
            for (int j = 0; j < 4; ++j) { const f32x4 fv = *(const LAS f32x4*)(wsf + 8 * j + 4 * hi);
#pragma unroll
                for (int i = 0; i < 4; ++i) { o[0][4 * j + i] *= fv[i]; o[1][4 * j + i] *= fv[i]; } }
        }
        l_reg += sacc;
#pragma unroll
        for (int k = 0; k < 2; ++k) {
            pw[k] = (u32x4){cvt_pk_bf16(p0[8 * k], p0[8 * k + 1]), cvt_pk_bf16(p0[8 * k + 2], p0[8 * k + 3]), cvt_pk_bf16(p0[8 * k + 4], p0[8 * k + 5]), cvt_pk_bf16(p0[8 * k + 6], p0[8 * k + 7])};
            pw[2 + k] = (u32x4){cvt_pk_bf16(p1[8 * k], p1[8 * k + 1]), cvt_pk_bf16(p1[8 * k + 2], p1[8 * k + 3]), cvt_pk_bf16(p1[8 * k + 4], p1[8 * k + 5]), cvt_pk_bf16(p1[8 * k + 6], p1[8 * k + 7])};
        }
        if (grp) pend = true; else ATT_PV(pw, slc);
    }
    if (grp && pend) ATT_PV(pw, slp);
#undef ATT_PV
    l_reg = xsum32(l_reg);
    if (hi == 0) wsf[32 + r32] = l_reg;
    LDS_WAIT();
    float rli[16];
#pragma unroll
    for (int j = 0; j < 4; ++j) { const f32x4 f = *(const LAS f32x4*)(wsf + 32 + 8 * j + 4 * hi);
#pragma unroll
        for (int i = 0; i < 4; ++i) rli[4 * j + i] = frcp(f[i]); }
    { LAS bf16_t* stg = (LAS bf16_t*)(shm3 + OST_OFF) + wid * 2048;
#pragma unroll
      for (int r = 0; r < 16; ++r) { const int orow = crow(r, hi);
#pragma unroll
          for (int d0 = 0; d0 < 2; ++d0) stg[orow * 64 + d0 * 32 + r32] = (bf16_t)(cvt_pk_bf16(o[d0][r] * rli[r], 0.f) & 0xffffu); }
      LDS_WAIT();
      bf16_t* Ow = O + (rowbase + q0 + wid * 32) * (size_t)AOO_LD + h * DV;
#pragma unroll
      for (int i = 0; i < 4; ++i) { const int row = i * 8 + (lane >> 3), ch = lane & 7; const u32x4 v = *(const LAS u32x4*)(stg + row * 64 + ch * 8); *(u32x4*)(Ow + (size_t)row * AOO_LD + ch * 8) = v; } }
    asm volatile("s_waitcnt lgkmcnt(0)\n\ts_barrier" ::: "memory");
#undef ATT_DMA
}
}

__device__ __forceinline__ void gmlp_phase(int first, int stride, int nunits, const bf16_t* U, const bf16_t* Vg, const float* vstp, const float* vng, const float* vnb,
                                           const float* wsp, const float* bsp, bf16_t* AO, LAS unsigned char* lds) {
    int tid = threadIdx.x; asm volatile("" : "+v"(tid));
    const int lane = tid & 63, r32 = lane & 31, hi = lane >> 5; const int wid = __builtin_amdgcn_readfirstlane(tid >> 6);
    LAS bf16_t* vnT = (LAS bf16_t*)lds;
    LAS float* st = (LAS float*)(lds + 34816);
    LAS float* MX = (LAS float*)(lds + 36864);
    const int tb = wid >> 1, dh = wid & 1, nk = 2 * (tb + 1);
    const int trow = 32 * tb + r32, dch0 = tid & 15;
#define GM_LOAD(L_, SP, VG, UU) do { const size_t r0_ = (size_t)((L_) >> 7) * SEQ + (size_t)(((L_) >> 3) & 15) * 128; const int g_ = (L_) & 7; \
        if (tid < 128) { const float* p_ = vstp + (r0_ + tid) * 32; _Pragma("unroll") for (int j = 0; j < 8; ++j) SP[j] = *(const f32x4*)(p_ + 4 * j); } \
        _Pragma("unroll") for (int j = 0; j < 4; ++j) { const int q_ = tid + 512 * j, s_ = q_ >> 4; const size_t o_ = (r0_ + s_) * D + 128 * g_ + 8 * dch0; \
            VG[j] = ld_nt(Vg + o_); UU[j] = ld_nt(U + o_); } } while (0)
    int L = first; if (L >= nunits) return;
    f32x4 spA[8]; u32x4 vgA[4], uuA[4];
    GM_LOAD(L, spA, vgA, uuA);
    int gcur = -1; bf16x8 wa[8]; f32x4 bs4[4], g0, g1, b0, b1;
    while (L < nunits) {
        const int Ln = L + stride;
        f32x4 spB[8]; u32x4 vgB[4], uuB[4];
        if (Ln < nunits) GM_LOAD(Ln, spB, vgB, uuB);
        const int g = L & 7; const size_t r0 = (size_t)(L >> 7) * SEQ + (size_t)((L >> 3) & 15) * 128;
        if (g != gcur) { gcur = g;
            const float* wrow = wsp + ((size_t)g * 128 + trow) * 128 + 8 * hi;
#pragma unroll
            for (int kk = 0; kk < 8; ++kk) if (kk < nk) { f32x4 w0 = *(const f32x4*)(wrow + 16 * kk), w1 = *(const f32x4*)(wrow + 16 * kk + 4); const int s0 = 16 * kk + 8 * hi;
#pragma unroll
                for (int e = 0; e < 4; ++e) { if (s0 + e > trow) w0[e] = 0.f; if (s0 + 4 + e > trow) w1[e] = 0.f; }
                wa[kk] = __builtin_bit_cast(bf16x8, pack8(w0, w1)); }
#pragma unroll
            for (int j = 0; j < 4; ++j) bs4[j] = *(const f32x4*)(bsp + g * 128 + 32 * tb + 8 * j + 4 * hi);
            g0 = *(const f32x4*)(vng + 128 * g + 8 * dch0); g1 = *(const f32x4*)(vng + 128 * g + 8 * dch0 + 4);
            b0 = *(const f32x4*)(vnb + 128 * g + 8 * dch0); b1 = *(const f32x4*)(vnb + 128 * g + 8 * dch0 + 4); }
        if (tid < 128) { float s1 = 0.f, s2 = 0.f;
#pragma unroll
            for (int j = 0; j < 8; ++j) { s1 += spA[j].x + spA[j].z; s2 += spA[j].y + spA[j].w; }
            const float mean = s1 * (1.0f / D); const float var = s2 * (1.0f / D) - mean * mean;
            st[tid] = mean; st[128 + tid] = frsq(var + EPS); }
        LDS_WAIT(); RAW_BAR();
#pragma unroll
        for (int j = 0; j < 4; ++j) { const int q = tid + 512 * j, s_ = q >> 4;
            const float mean = st[s_], rstd = st[128 + s_]; const u32x4 w = vgA[j];
            float v[8] = {bf_lo(w.x), bf_hi(w.x), bf_lo(w.y), bf_hi(w.y), bf_lo(w.z), bf_hi(w.z), bf_lo(w.w), bf_hi(w.w)};
#pragma unroll
            for (int e = 0; e < 8; ++e) { const float gg = e < 4 ? g0[e] : g1[e - 4], bb = e < 4 ? b0[e] : b1[e - 4];
                vnT[(8 * dch0 + e) * 136 + (s_ ^ (8 * dch0))] = (bf16_t)(cvt_pk_bf16((v[e] - mean) * rstd * gg + bb, 0.f) & 0xffffu); } }
        LDS_WAIT(); RAW_BAR();
        f32x16 acc[2]; acc[0] = f32x16{}; acc[1] = f32x16{};
#pragma unroll
        for (int kk = 0; kk < 8; kk += 2) if (kk < nk) {
            bf16x8 bfr[2][2];
#pragma unroll
            for (int k2 = 0; k2 < 2; ++k2) { const int s0 = 16 * (kk + k2) + 8 * hi;
#pragma unroll
                for (int db = 0; db < 2; ++db) bfr[k2][db] = *(const LAS bf16x8*)(vnT + (64 * dh + 32 * db + r32) * 136 + (s0 ^ (8 * (8 * dh + 4 * db + (r32 >> 3))))); }
            __builtin_amdgcn_sched_barrier(0);
#pragma unroll
            for (int k2 = 0; k2 < 2; ++k2)
#pragma unroll
                for (int db = 0; db < 2; ++db) acc[db] = __builtin_amdgcn_mfma_f32_32x32x16_bf16(wa[kk + k2], bfr[k2][db], acc[db], 0, 0, 0);
        }
#pragma unroll
        for (int r = 0; r < 16; ++r) { const int t = 32 * tb + crow(r, hi); const float bs = bs4[r >> 2][r & 3];
#pragma unroll
            for (int db = 0; db < 2; ++db) MX[t * 132 + 64 * dh + 32 * db + r32] = acc[db][r] + bs; }
        LDS_WAIT(); RAW_BAR();
#pragma unroll
        for (int j = 0; j < 4; ++j) { const int q = tid + 512 * j, s_ = q >> 4;
            const f32x4 m0 = *(const LAS f32x4*)(MX + s_ * 132 + 8 * dch0), m1 = *(const LAS f32x4*)(MX + s_ * 132 + 8 * dch0 + 4); const u32x4 w = uuA[j];
            const f32x4 ua = {bf_lo(w.x), bf_hi(w.x), bf_lo(w.y), bf_hi(w.y)}, ub = {bf_lo(w.z), bf_hi(w.z), bf_lo(w.w), bf_hi(w.w)};
            *(u32x4*)(AO + (r0 + s_) * AOO_LD + 128 * g + 8 * dch0) = pack8(ua * m0, ub * m1); }
#pragma unroll
        for (int j = 0; j < 8; ++j) spA[j] = spB[j];
#pragma unroll
        for (int j = 0; j < 4; ++j) { vgA[j] = vgB[j]; uuA[j] = uuB[j]; }
        L = Ln;
    }
#undef GM_LOAD
    LDS_WAIT(); RAW_BAR();
}

typedef const __attribute__((address_space(4))) unsigned char* kargp_t;
__device__ __forceinline__ kargp_t kargp() { kargp_t k = (kargp_t)__builtin_amdgcn_kernarg_segment_ptr(); asm volatile("" : "+s"(k)); return k; }
#define KARG(off, T) (*(T const __attribute__((address_space(4)))*)(kargp() + (off)))
#define INP(i) KARG(8 * (i), const float*)
#define OUTP() KARG(184, float*)
#define WSP() KARG(192, unsigned char*)

struct MapNat { __device__ __forceinline__ int operator()(int j4) const { return j4; } };
struct MapW1 { __device__ __forceinline__ int operator()(int j4) const { const int j = 4 * j4;
    if (j < 2816) return j4; if (j >= 3072) return (2848 + (j - 3072)) >> 2; const int p = j - 2816; if (p >= 32) return -1; return (2816 + 16 * ((p >> 2) & 1) + 4 * (p >> 3)) >> 2; } };
struct MapUQ { __device__ __forceinline__ int operator()(int j4) const { const int j = 4 * j4, t = j >> 8, p = j & 255, bj = p >> 7, wc = (p >> 5) & 3, q = p & 31; const int head = 2 * t + (wc >> 1);
    int dim; if (bj == 0) dim = 32 * (wc & 1) + q; else { if (wc & 1) return -1; dim = 64 + 16 * ((q >> 2) & 1) + 4 * (q >> 3); } return (head * DQK + dim) >> 2; } };
struct MapUKV { __device__ __forceinline__ int operator()(int j4) const { const int j = 4 * j4, t = j >> 8, p = j & 255, bj = p >> 7, wc = (p >> 5) & 3, q = p & 31;
    return ((2 * t + (wc >> 1)) * 128 + (wc & 1) * 64 + 32 * bj + q) >> 2; } };
struct MapGU { __device__ __forceinline__ int operator()(int j4) const { const int j = 4 * j4, t = j >> 8, bj = (j >> 7) & 1, q = j & 127; return (bj * FF + 128 * t + q) >> 2; } };

struct TrDesc { const float* W; bf16_t* WT; const float* scale; float mul; int K, Nsrc, mtype, item, ldw, esz; };
__device__ __forceinline__ int tr_map(int mtype, int j4) {
    switch (mtype) { case 1: return MapW1()(j4); case 2: return MapUQ()(j4); case 3: return MapUKV()(j4); case 4: return MapGU()(j4); default: return j4; } }
__device__ __forceinline__ void tr_load(const TrDesc& d, f32x4 (&v)[16], int lane) {
    const int nblk_k = d.K >> 6; const int nb = d.item / nblk_k, kb = d.item - nb * nblk_k; const int k0 = kb * 64, n0 = nb * 64;
    const int g4 = lane & 15, c = lane >> 4;
    const int src4 = tr_map(d.mtype, (n0 >> 2) + g4);
#pragma unroll
    for (int p = 0; p < 2; ++p) { const int kk = k0 + 32 * p + 8 * c;
        f32x4 sc0 = {1.f, 1.f, 1.f, 1.f}, sc1 = sc0; if (d.scale) { sc0 = *(const f32x4*)(d.scale + kk); sc1 = *(const f32x4*)(d.scale + kk + 4); }
#pragma unroll
        for (int i = 0; i < 8; ++i) { const float sc = i < 4 ? sc0[i] : sc1[i - 4];
            if (src4 >= 0) v[8 * p + i] = __builtin_nontemporal_load((const f32x4*)(d.W + (size_t)(kk + i) * d.Nsrc + 4 * src4)) * (sc * d.mul); else v[8 * p + i] = (f32x4){0.f, 0.f, 0.f, 0.f}; } }
}
__device__ __forceinline__ void tr_store(const TrDesc& d, const f32x4 (&v)[16], LAS float*, int lane) {
    const int nblk_k = d.K >> 6; const int nb = d.item / nblk_k, kb = d.item - nb * nblk_k; const int k0 = kb * 64, n0 = nb * 64;
    const int g4 = lane & 15, c = lane >> 4;
    if (d.esz == 1) {
#pragma unroll
        for (int j = 0; j < 4; ++j) {
            const u32x2 c0 = pack8_f8((f32x4){v[0][j], v[1][j], v[2][j], v[3][j]}, (f32x4){v[4][j], v[5][j], v[6][j], v[7][j]});
            const u32x2 c1 = pack8_f8((f32x4){v[8][j], v[9][j], v[10][j], v[11][j]}, (f32x4){v[12][j], v[13][j], v[14][j], v[15][j]});
            const auto t0 = __builtin_amdgcn_permlane32_swap(c0.x, c1.x, false, false), t1 = __builtin_amdgcn_permlane32_swap(c0.y, c1.y, false, false);
            const auto u0 = __builtin_amdgcn_permlane16_swap(t0[0], t0[1], false, false), u1 = __builtin_amdgcn_permlane16_swap(t1[0], t1[1], false, false);
            *(u32x4*)((unsigned char*)d.WT + (size_t)(n0 + 4 * g4 + j) * d.ldw + k0 + 16 * c) = (u32x4){u0[0], u1[0], u0[1], u1[1]}; }
        return; }
#pragma unroll
    for (int p = 0; p < 2; ++p)
#pragma unroll
        for (int j = 0; j < 4; ++j) {
            { u32x4 o;
            o.x = cvt_pk_bf16(v[8 * p + 0][j], v[8 * p + 1][j]); o.y = cvt_pk_bf16(v[8 * p + 2][j], v[8 * p + 3][j]); o.z = cvt_pk_bf16(v[8 * p + 4][j], v[8 * p + 5][j]); o.w = cvt_pk_bf16(v[8 * p + 6][j], v[8 * p + 7][j]);
            *(u32x4*)(d.WT + (size_t)(n0 + 4 * g4 + j) * d.ldw + k0 + 32 * p + 8 * c) = o; } }
}
constexpr int TR_LAYER = 2432, TR_DENSE = 2112, TR_EXP = 2112, TR_TOTAL = 2 * TR_LAYER + TR_DENSE + 8 * TR_EXP;
__device__ __forceinline__ TrDesc tr_decode(int it, unsigned char* ws) {
    TrDesc d; d.scale = nullptr; d.mtype = 0; d.mul = 1.0f; d.esz = 2;
    if (it < 2 * TR_LAYER) { const int l = it / TR_LAYER; int r = it - l * TR_LAYER; unsigned char* wl = ws + WS_WL + l * WL_STRIDE;
        if (r < 1280) { d.ldw = D; d.W = INP(2) + (size_t)l * D * DIN; d.K = D; d.Nsrc = DIN; d.WT = (bf16_t*)(wl + WL_W1T); d.scale = INP(1) + l * D; d.mtype = 1; d.item = r; return d; } r -= 1280;
        if (r < 256) { d.ldw = QL; d.W = INP(9) + (size_t)l * QL * (NH * DQK); d.K = QL; d.Nsrc = NH * DQK; d.WT = (bf16_t*)(wl + WL_WUQ); d.scale = INP(8) + l * QL; d.mtype = 2; d.item = r; return d; } r -= 256;
        if (r < 128) { d.ldw = KVL; d.W = INP(11) + (size_t)l * KVL * (NH * 128); d.K = KVL; d.Nsrc = NH * 128; d.WT = (bf16_t*)(wl + WL_WUKV); d.scale = INP(10) + l * KVL; d.mtype = 3; d.item = r; return d; } r -= 128;
        const int w = r >> 8; d.item = r & 255; d.K = D; d.Nsrc = D;
        d.W = (w == 0 ? INP(7) : w == 1 ? INP(14) : INP(15)) + (size_t)l * D * D; d.ldw = (w == 2) ? D : 2 * D;
        d.WT = (w == 2) ? (bf16_t*)(wl + WL_WOUT) : (bf16_t*)(wl + WL_PA) + w * D; return d; }
    it -= 2 * TR_LAYER;
    if (it < TR_DENSE) {
        if (it < 1408) { d.ldw = D; d.W = INP(17); d.K = D; d.Nsrc = 2 * FF; d.WT = (bf16_t*)(ws + WS_WGU); d.scale = INP(16); d.mtype = 4; d.item = it; return d; }
        d.ldw = FF; d.W = INP(18); d.K = FF; d.Nsrc = D; d.WT = (bf16_t*)(ws + WS_WD); d.item = it - 1408; return d; }
    it -= TR_DENSE;
    const int e = it / TR_EXP; const int r = it - e * TR_EXP;
    if (r < 1408) { d.ldw = D; d.W = INP(21) + (size_t)e * D * 2 * FF; d.K = D; d.Nsrc = 2 * FF; d.WT = (bf16_t*)(ws + WS_MGU + (size_t)e * 2 * FF * D * MESZ); d.scale = INP(16) + D; d.mtype = 4; d.item = r; d.mul = W8_SCALE; d.esz = MESZ; return d; }
    d.ldw = FF; d.W = INP(22) + (size_t)e * FF * D; d.K = FF; d.Nsrc = D; d.WT = (bf16_t*)(ws + WS_MD + (size_t)e * D * FF * MESZ); d.item = r - 1408; d.mul = W8_SCALE; d.esz = MESZ; return d;
}


#ifndef DBG_STOP
#define DBG_STOP (-1)
#endif
__device__ __forceinline__ void dump_bf16(float* out, const bf16_t* src, size_t n, bool first) {
    const size_t gt = (size_t)blockIdx.x * 512 + threadIdx.x, gs = (size_t)gridDim.x * 512;
    for (size_t i = gt; i < (size_t)M * D; i += gs) { float a = first ? 0.f : out[i]; for (size_t j = i; j < n; j += (size_t)M * D) a += bf1(src[j]); out[i] = a; } }
__device__ __forceinline__ void dump_f32(float* out, const float* src, size_t n, bool first) {
    const size_t gt = (size_t)blockIdx.x * 512 + threadIdx.x, gs = (size_t)gridDim.x * 512;
    for (size_t i = gt; i < (size_t)M * D; i += gs) { float a = first ? 0.f : out[i]; for (size_t j = i; j < n; j += (size_t)M * D) a += src[j]; out[i] = a; } }
#define DBG_AT(id, ...) do { if (DBG_STOP == (id)) { GRID_BAR(); unsigned char* ws = WSP(); float* out = OUTP(); (void)ws; __VA_ARGS__; return; } } while (0)
struct Params { const float* in[23]; float* out; unsigned char* ws; int mode, pad; };
static_assert(sizeof(Params) == 208, "kernarg layout");
#ifndef DBG_TWO
#define DBG_TWO 0
#endif
#ifndef REP_MASK
#define REP_MASK 0
#endif
#define REP(id) for (int rep_ = 0; rep_ < (((REP_MASK) >> (id)) & 1) + 1; ++rep_)

__global__ void __launch_bounds__(512, 2) fwd_kernel(Params p) {
    extern __shared__ __attribute__((aligned(16))) unsigned char lds_raw[];
    LAS unsigned char* lds = (LAS unsigned char*)lds_raw;
    { const int tid = threadIdx.x; volatile LAS unsigned* MISC = (volatile LAS unsigned*)(lds + MISC_OFF);
      for (int u = tid; u < 64; u += 512) MISC[u] = 0u;
      __syncthreads();
      (void)xcd_barrier_post((unsigned*)(WSP() + WS_CTL) + CW_BAR, MISC + 8); }
#ifndef BAR_REP
#define BAR_REP 1
#endif
#define GRID_BAR() for (int br_ = 0; br_ < BAR_REP; ++br_) do { XcdBarrier b_; b_.bar = (unsigned*)(WSP() + WS_CTL) + CW_BAR; b_.x = xb_xcc_id(); b_.st = (volatile LAS unsigned*)(lds + MISC_OFF) + 8; xcd_barrier(b_); } while (0)
#define GRID_G ((int)gridDim.x)
#define GRID_BX ((int)blockIdx.x)
#define VCU ((GRID_G % 8 == 0) ? (GRID_BX % 8) * (GRID_G / 8) + GRID_BX / 8 : GRID_BX)

    REP(0) if (!DBG_TWO || KARG(200, int) != 2) {
        unsigned char* ws = WSP();
        int tid = threadIdx.x; asm volatile("" : "+v"(tid)); const int lane = tid & 63, wave = __builtin_amdgcn_readfirstlane(tid >> 6);
        const int G = GRID_G, bx = GRID_BX; const int gw = VCU * 8 + wave, NGW = G * 8;
        LAS float* scr = (LAS float*)(lds + wave * 16640);
        {
            f32x4 va[16], vb[16], vc[16]; int it = gw;
            TrDesc da = tr_decode(TR_TOTAL - 1 - it, ws), db = da, dc = da;
            tr_load(da, va, lane);
            if (it + NGW < TR_TOTAL) { db = tr_decode(TR_TOTAL - 1 - (it + NGW), ws); tr_load(db, vb, lane); }
            while (it < TR_TOTAL) {
                if (it + 2 * NGW < TR_TOTAL) { dc = tr_decode(TR_TOTAL - 1 - (it + 2 * NGW), ws); tr_load(dc, vc, lane); }
                tr_store(da, va, scr, lane); it += NGW; if (it >= TR_TOTAL) break;
                if (it + 2 * NGW < TR_TOTAL) { da = tr_decode(TR_TOTAL - 1 - (it + 2 * NGW), ws); tr_load(da, va, lane); }
                tr_store(db, vb, scr, lane); it += NGW; if (it >= TR_TOTAL) break;
                if (it + 2 * NGW < TR_TOTAL) { db = tr_decode(TR_TOTAL - 1 - (it + 2 * NGW), ws); tr_load(db, vb, lane); }
                tr_store(dc, vc, scr, lane); it += NGW;
            }
        }
        { const float* x = INP(0); bf16_t* XB = (bf16_t*)(ws + WS_XB); float* xssp = (float*)(ws + WS_XSSP);
          for (int m0 = gw; m0 < M; m0 += 4 * NGW) {
            f32x4 v[4][4];
#pragma unroll
            for (int q = 0; q < 4; ++q) { const int m = m0 + q * NGW; if (m < M) { const f32x4* xr = (const f32x4*)(x + (size_t)m * D) + lane;
#pragma unroll
                for (int j = 0; j < 4; ++j) v[q][j] = __builtin_nontemporal_load(xr + 64 * j); } }
            __builtin_amdgcn_sched_barrier(0);
#pragma unroll
            for (int q = 0; q < 4; ++q) { const int m = m0 + q * NGW; if (m < M) { float s = 0.f; u32x2* o8 = (u32x2*)(XB + (size_t)m * D) + lane;
#pragma unroll
                for (int j = 0; j < 4; ++j) { s += sum4(v[q][j] * v[q][j]); o8[64 * j] = (u32x2){cvt_pk_bf16(v[q][j].x, v[q][j].y), cvt_pk_bf16(v[q][j].z, v[q][j].w)}; }
                s = wave_sum(s);
                if (lane == 0) *(f32x4*)(xssp + (size_t)m * 4) = (f32x4){s, 0.f, 0.f, 0.f}; } }
          } }
        for (int i = bx * 512 + tid; i < SEQ * 16; i += G * 512) { const int pos = i >> 4, j = i & 15;
            const float inv = powf(10000.0f, -(float)(2 * j) / 32.0f); const float ang = (float)pos * inv;
            ((float*)(ws + WS_ROPE))[i] = cosf(ang); ((float*)(ws + WS_ROPE))[SEQ * 16 + i] = sinf(ang); }
    }
    if (DBG_TWO && KARG(200, int) == 1) return;
    GRID_BAR();
    DBG_AT(0, dump_bf16(out, (const bf16_t*)(ws + WS_XB), (size_t)M * D, true); dump_f32(out, (const float*)(ws + WS_ROPE), (size_t)SEQ * 32 + (size_t)M * 4, false); dump_bf16(out, (const bf16_t*)(ws + WS_WL), (WS_WD + (size_t)D * FF * 2 - WS_WL) / 2, false); dump_bf16(out, (const bf16_t*)(ws + WS_MGU), (WS_XB - WS_MGU) / 2, false));

#pragma unroll 1
    for (int l = 0; l < 2; ++l) {
        REP(1) {
            unsigned char* ws = WSP(); unsigned char* wl = ws + WS_WL + l * WL_STRIDE;
            const float* cosT = (const float*)(ws + WS_ROPE); const float* sinT = cosT + SEQ * 16;
            SchedStd S; S.init(M / 256, N1 / 256, GRID_G, GRID_BX); S.A = (const char*)(ws + WS_XB); S.Bt = (const char*)(wl + WL_W1T); S.astep = 256 * (size_t)D * 2; S.bstep = 256 * (size_t)D * 2;
            EpiG1 E{(const float*)(ws + WS_XSSP), (bf16_t*)(ws + WS_U), (bf16_t*)(ws + WS_VG), (bf16_t*)(ws + WS_CQ), (bf16_t*)(ws + WS_CKV), (bf16_t*)(ws + WS_G),
                    (float*)(ws + WS_VSTP), (float*)(ws + WS_CQP), (float*)(ws + WS_CKVP), (float*)(ws + WS_KR), (float*)(ws + WS_KRSS), INP(13) + l * DQK, cosT, sinT};
#if DBG_STOP == 21
            EpiRaw ER{(bf16_t*)(ws + WS_U), N1};
            pg8::gemm_phase<EpiRaw, SchedStd, true, false>(lds, D, D, D, S, ER);
#else
            pg8::gemm_phase<EpiG1, SchedStd, true, false>(lds, D, D, D, S, E);
#endif
        }
        GRID_BAR();
        DBG_AT(21, dump_bf16(out, (const bf16_t*)(ws + WS_U), (size_t)M * N1, true));
        if (DBG_STOP == 10 * l + 1) DBG_AT(10 * l + 1, dump_bf16(out, (const bf16_t*)(ws + WS_U), (size_t)M * 4096, true); dump_bf16(out, (const bf16_t*)(ws + WS_CQ), (size_t)M * 768, false); dump_f32(out, (const float*)(ws + WS_VSTP), (size_t)M * 32, false); dump_f32(out, (const float*)(ws + WS_CQP), (size_t)M * 8, false); dump_f32(out, (const float*)(ws + WS_CKVP), (size_t)M * 4, false); dump_f32(out, (const float*)(ws + WS_KRSS), (size_t)M, false); dump_f32(out, (const float*)(ws + WS_KR), (size_t)M * 32, false));
        REP(2) {
            unsigned char* ws = WSP(); unsigned char* wl = ws + WS_WL + l * WL_STRIDE;
            const float* cosT = (const float*)(ws + WS_ROPE); const float* sinT = cosT + SEQ * 16;
            SchedStd S; S.init(M / 256, NQ / 256, GRID_G, GRID_BX); S.A = (const char*)(ws + WS_CQ); S.Bt = (const char*)(wl + WL_WUQ); S.astep = 256 * (size_t)QL * 2; S.bstep = 256 * (size_t)QL * 2;
            EpiQ E{(const float*)(ws + WS_CQP), INP(12) + l * DQK, cosT, sinT, (bf16_t*)(ws + WS_Q)};
            pg8::gemm_phase<EpiQ, SchedStd, true, false>(lds, QL, QL, QL, S, E);
        }
        REP(3) {
            unsigned char* ws = WSP(); unsigned char* wl = ws + WS_WL + l * WL_STRIDE;
            SchedStd S; S.init(M / 256, NKV / 256, GRID_G, GRID_BX); S.A = (const char*)(ws + WS_CKV); S.Bt = (const char*)(wl + WL_WUKV); S.astep = 256 * (size_t)KVL * 2; S.bstep = 256 * (size_t)KVL * 2;
            EpiKV E{(const float*)(ws + WS_CKVP), (const float*)(ws + WS_KRSS), (const float*)(ws + WS_KR), INP(13) + l * DQK, (bf16_t*)(ws + WS_KT), (bf16_t*)(ws + WS_VT)};
            pg8::gemm_phase<EpiKV, SchedStd, true, false>(lds, KVL, KVL, KVL, S, E);
        }
        REP(4) {
            unsigned char* ws = WSP();
            gmlp_phase(VCU, GRID_G, NBATCH * 16 * 8, (const bf16_t*)(ws + WS_U), (const bf16_t*)(ws + WS_VG), (const float*)(ws + WS_VSTP), INP(3) + l * D, INP(4) + l * D,
                       INP(5) + (size_t)l * 8 * 128 * 128, INP(6) + l * 8 * 128, (bf16_t*)(ws + WS_AO), lds);
        }
        GRID_BAR();
        if (DBG_STOP == 10 * l + 2) DBG_AT(10 * l + 2, dump_bf16(out, (const bf16_t*)(ws + WS_Q), (size_t)M * (1536 + 1536 + 1024 + 1024), true));
        if (DBG_STOP == 10 * l + 9) DBG_AT(10 * l + 9, dump_bf16(out, (const bf16_t*)(ws + WS_Q), (size_t)M * 1536, true));
        if (DBG_STOP == 10 * l + 8) DBG_AT(10 * l + 8, dump_bf16(out, (const bf16_t*)(ws + WS_AO), (size_t)M * 1024, true));
        REP(5) {
            unsigned char* ws = WSP();
            for (int L = VCU; L < NBATCH * NH * 4; L += GRID_G) {
                const int bh = L >> 2, pr = L & 3;
                att::attn_unit(bh >> 4, bh & 15, 7 - pr, (const bf16_t*)(ws + WS_Q), (const bf16_t*)(ws + WS_KT), (const bf16_t*)(ws + WS_VT), (bf16_t*)(ws + WS_AO) + 1024, (char*)lds_raw);
                att::attn_unit(bh >> 4, bh & 15, pr, (const bf16_t*)(ws + WS_Q), (const bf16_t*)(ws + WS_KT), (const bf16_t*)(ws + WS_VT), (bf16_t*)(ws + WS_AO) + 1024, (char*)lds_raw);
            }
        }
        GRID_BAR();
        if (DBG_STOP == 10 * l + 3) DBG_AT(10 * l + 3, dump_bf16(out, (const bf16_t*)(ws + WS_O), (size_t)M * D, true));
        REP(6) {
            unsigned char* ws = WSP(); unsigned char* wl = ws + WS_WL + l * WL_STRIDE;
            SchedStd S; S.init(M / 256, D / 256, GRID_G, GRID_BX); S.A = (const char*)(ws + WS_AO); S.Bt = (const char*)(wl + WL_PA); S.astep = 256 * (size_t)AOO_LD * 2; S.bstep = 256 * (size_t)(2 * D) * 2;
            EpiProjF E{(const bf16_t*)(ws + WS_G), (bf16_t*)(ws + WS_MG)};
            pg8::gemm_phase<EpiProjF, SchedStd, true, false>(lds, 2 * D, AOO_LD, 2 * D, S, E);
        }
        GRID_BAR();
        if (DBG_STOP == 10 * l + 4) DBG_AT(10 * l + 4, dump_bf16(out, (const bf16_t*)(ws + WS_MG), (size_t)M * D, true));
        REP(7) {
            unsigned char* ws = WSP(); unsigned char* wl = ws + WS_WL + l * WL_STRIDE;
            SchedStd S; S.init(M / 256, D / 256, GRID_G, GRID_BX); S.A = (const char*)(ws + WS_MG); S.Bt = (const char*)(wl + WL_WOUT); S.astep = 256 * (size_t)D * 2; S.bstep = 256 * (size_t)D * 2;
            EpiRes E{(l == 0) ? INP(0) : (const float*)(ws + WS_X2), (l == 0) ? (float*)(ws + WS_X1) : OUTP(), (bf16_t*)(ws + WS_XB), (float*)(ws + WS_XSSP), (MOE_FP8 && l == 1) ? (unsigned char*)(ws + WS_XB8) : nullptr};
            pg8::gemm_phase<EpiRes, SchedStd, false, false>(lds, D, D, D, S, E);
        }
        GRID_BAR();
        if (DBG_STOP == 5 && l == 0) DBG_AT(5, dump_f32(out, (const float*)(ws + WS_X1), (size_t)M * D, true); dump_f32(out, (const float*)(ws + WS_XSSP), (size_t)M * 4, false); dump_bf16(out, (const bf16_t*)(ws + WS_XB), (size_t)M * D, false));
        if (DBG_STOP == 15 && l == 1) return;
        if (l == 0) {
            REP(8) {
                unsigned char* ws = WSP();
                SchedStd S; S.init(M / 256, 2 * FF / 256, GRID_G, GRID_BX); S.A = (const char*)(ws + WS_XB); S.Bt = (const char*)(ws + WS_WGU); S.astep = 256 * (size_t)D * 2; S.bstep = 256 * (size_t)D * 2;
                EpiGU<false> E{(const float*)(ws + WS_XSSP), (bf16_t*)(ws + WS_ACT), nullptr};
                pg8::gemm_phase<EpiGU<false>, SchedStd, true, false>(lds, D, D, D, S, E);
            }
            GRID_BAR();
            DBG_AT(6, dump_bf16(out, (const bf16_t*)(ws + WS_ACT), (size_t)M * FF, true));
            REP(9) {
                unsigned char* ws = WSP();
                SchedStd S; S.init(M / 256, D / 256, GRID_G, GRID_BX); S.A = (const char*)(ws + WS_ACT); S.Bt = (const char*)(ws + WS_WD); S.astep = 256 * (size_t)FF * 2; S.bstep = 256 * (size_t)FF * 2;
                EpiRes E{(const float*)(ws + WS_X1), (float*)(ws + WS_X2), (bf16_t*)(ws + WS_XB), (float*)(ws + WS_XSSP), nullptr};
                pg8::gemm_phase<EpiRes, SchedStd, false, false>(lds, FF, FF, FF, S, E);
            }
            GRID_BAR();
            DBG_AT(7, dump_f32(out, (const float*)(ws + WS_X2), (size_t)M * D, true); dump_f32(out, (const float*)(ws + WS_XSSP), (size_t)M * 4, false));
        } else {
            {
                unsigned char* ws = WSP(); unsigned* ctl = (unsigned*)(ws + WS_CTL);
                int tid = threadIdx.x; asm volatile("" : "+v"(tid)); const int lane = tid & 63, wave = __builtin_amdgcn_readfirstlane(tid >> 6);
                int* idxt = (int*)(ws + WS_IDXT); float* idxw = (float*)(ws + WS_IDXW); const float* xssp = (const float*)(ws + WS_XSSP);
                LAS int* lcnt = (LAS int*)lds; LAS int* lstart = lcnt + 8; LAS int* lsel = lcnt + 16;
                LAS float* lw = (LAS float*)(lcnt + 16 + 128);
                const float* wr_ = INP(19); const float* br_ = INP(20); const float* gf = INP(16) + D; const float* xo = OUTP();
                f32x4 w0r[16], w1r[16];
#pragma unroll
                for (int j = 0; j < 4; ++j)
#pragma unroll
                    for (int i = 0; i < 4; ++i) { const int k = 4 * lane + 256 * j + i; const float gk_ = gf[k];
                        w0r[4 * j + i] = *(const f32x4*)(wr_ + (size_t)k * 8) * gk_; w1r[4 * j + i] = *(const f32x4*)(wr_ + (size_t)k * 8 + 4) * gk_; }
                for (int chunk = GRID_BX; chunk < M / 64; chunk += GRID_G) {
                    if (tid < 8) lcnt[tid] = 0;
                    __syncthreads();
                    u32x2 xn_[4];
#pragma unroll
                    for (int j = 0; j < 4; ++j) xn_[j] = *(const u32x2*)((const bf16_t*)(ws + WS_XB) + (size_t)(chunk * 64 + wave * 8) * D + 4 * lane + 256 * j);
                    f32x4 xsn_ = *(const f32x4*)(xssp + (size_t)(chunk * 64 + wave * 8) * 4);
#pragma unroll 1
                    for (int q = 0; q < 8; ++q) { const int tl = wave * 8 + q; const int tk = chunk * 64 + tl;
                        u32x2 xc_[4];
#pragma unroll
                        for (int j = 0; j < 4; ++j) xc_[j] = xn_[j];
                        const f32x4 xsc_ = xsn_;
                        { const int tkn = tk + (q < 7 ? 1 : 0);
#pragma unroll
                          for (int j = 0; j < 4; ++j) xn_[j] = *(const u32x2*)((const bf16_t*)(ws + WS_XB) + (size_t)tkn * D + 4 * lane + 256 * j);
                          xsn_ = *(const f32x4*)(xssp + (size_t)tkn * 4); }
                        __builtin_amdgcn_sched_barrier(0);
                        float a[8];
#pragma unroll
                        for (int e = 0; e < 8; ++e) a[e] = 0.f;
#pragma unroll
                        for (int j = 0; j < 4; ++j) { const int k0 = 4 * lane + 256 * j;
#if RES_BF16
                            const u32x2 xw_ = xc_[j]; const f32x4 xv = (f32x4){bf_lo(xw_.x), bf_hi(xw_.x), bf_lo(xw_.y), bf_hi(xw_.y)};
#else
                            const f32x4 xv = *(const f32x4*)(xo + (size_t)tk * D + k0) * *(const f32x4*)(gf + k0);
#endif

#pragma unroll
                            for (int i = 0; i < 4; ++i) { const f32x4 w0 = w0r[4 * j + i], w1 = w1r[4 * j + i];
                                a[0] += xv[i] * w0.x; a[1] += xv[i] * w0.y; a[2] += xv[i] * w0.z; a[3] += xv[i] * w0.w; a[4] += xv[i] * w1.x; a[5] += xv[i] * w1.y; a[6] += xv[i] * w1.z; a[7] += xv[i] * w1.w; } }
#pragma unroll
                        for (int e = 0; e < 8; ++e) a[e] = wave_sum(a[e]);
                        if (lane == 0) { const float rs = 1.0f / sqrtf(sum4(xsc_) * (1.0f / D) + EPS);
                            float lg[8];
#pragma unroll
                            for (int e = 0; e < 8; ++e) lg[e] = a[e] * rs + br_[e];
                            int e0 = 0; float v0 = lg[0];
#pragma unroll
                            for (int e = 1; e < 8; ++e) if (lg[e] > v0) { v0 = lg[e]; e0 = e; }
                            int e1 = -1; float v1 = -INFINITY;
#pragma unroll
                            for (int e = 0; e < 8; ++e) if (e != e0 && lg[e] > v1) { v1 = lg[e]; e1 = e; }
                            const float w1v = 1.0f / (1.0f + expf(v0 - v1)), w0v = 1.0f - w1v;
                            const int i0 = atomicAdd((int*)&lcnt[e0], 1), i1 = atomicAdd((int*)&lcnt[e1], 1);
                            lsel[tl * 2] = e0 | (i0 << 8); lsel[tl * 2 + 1] = e1 | (i1 << 8); lw[tl * 2] = w0v; lw[tl * 2 + 1] = w1v; }
                    }
                    __syncthreads();
                    if (tid < 8) lstart[tid] = (int)atomicAdd(ctl + CW_CNT + 64 * tid, (unsigned)lcnt[tid]);
                    __syncthreads();
                    if (tid < 128) { const int sel = lsel[tid]; const int e = sel & 255, li = sel >> 8; const int pos = lstart[e] + li;
                        const int tk_ = chunk * 64 + (tid >> 1); idxt[e * M + pos] = tk_; idxw[e * M + pos] = lw[tid]; ((int*)(ws + WS_TOKPOS))[chunk * 128 + tid] = e | (pos << 4);
                        ((float*)(ws + WS_IDXR))[e * M + pos] = frsq(sum4(*(const f32x4*)(xssp + (size_t)tk_ * 4)) * (1.0f / D) + EPS) * (1.0f / W8_SCALE); }
                    __syncthreads();
                }
            }
            GRID_BAR();
            REP(10) {
                unsigned char* ws = WSP(); unsigned* ctl = (unsigned*)(ws + WS_CTL);
                moe_table_build(lds, ctl + CW_CNT);
                SchedMoeGu S; S.tt = lds + MOE_TT_OFF; S.init(moe_table_tiles(lds), 2 * FF / 256, GRID_G, GRID_BX); S.XB = (const char*)(ws + (MOE_FP8 ? WS_XB8 : WS_XB)); S.W = (const char*)(ws + WS_MGU); S.idxt = (const int*)(ws + WS_IDXT);
                EpiGU<true> E{(const float*)(ws + WS_XSSP), (bf16_t*)(ws + WS_ACT2), (const float*)(ws + WS_IDXR)};
#if MOE_FP8
                pg8::gemm_phase_f8<EpiGU<true>, SchedMoeGu, true, true>(lds, D, D, D, S, E);
#else
                pg8::gemm_phase<EpiGU<true>, SchedMoeGu, true, true>(lds, D, D, D, S, E);
#endif
            }
            GRID_BAR();
            REP(11) {
                unsigned char* ws = WSP(); unsigned* ctl = (unsigned*)(ws + WS_CTL);
                moe_table_build(lds, ctl + CW_CNT);
                SchedMoeDn S; S.tt = lds + MOE_TT_OFF; S.init(moe_table_tiles(lds), GRID_G, GRID_BX); S.A = (const char*)(ws + WS_ACT2); S.W = (const char*)(ws + WS_MD);
                EpiMoeDn E{(bf16_t*)(ws + WS_Y), (const float*)(ws + WS_IDXW)};
#if MOE_FP8
                pg8::gemm_phase_f8<EpiMoeDn, SchedMoeDn, true, false>(lds, FF / 2, FF, FF, S, E);
#else
                pg8::gemm_phase<EpiMoeDn, SchedMoeDn, true, false>(lds, FF / 2, FF, FF, S, E);
#endif
            }
            GRID_BAR();
            {
                unsigned char* ws = WSP(); const unsigned* cntw = (const unsigned*)(ws + WS_CTL) + CW_CNT;
                int tid = threadIdx.x; asm volatile("" : "+v"(tid)); const int lane = tid & 63, wave = __builtin_amdgcn_readfirstlane(tid >> 6);
                int tsv[8]; { int a_ = 0, c_[8];
#pragma unroll
                    for (int e = 0; e < 8; ++e) c_[e] = (int)__hip_atomic_load(cntw + 64 * e, __ATOMIC_RELAXED, __HIP_MEMORY_SCOPE_AGENT);
                    __builtin_amdgcn_sched_barrier(0);
#pragma unroll
                    for (int e = 0; e < 8; ++e) { tsv[e] = a_ * 256; a_ += (__builtin_amdgcn_readfirstlane(c_[e]) + 255) >> 8; } }
                const int* tokpos = (const int*)(ws + WS_TOKPOS); const bf16_t* Y = (const bf16_t*)(ws + WS_Y); float* out = OUTP();
                for (int tk0 = (VCU * 8 + wave) * 4; tk0 < M; tk0 += GRID_G * 32) {
                    size_t s0[4], s1[4];
                    int tpv[4][2];
#pragma unroll
                    for (int q = 0; q < 4; ++q) { tpv[q][0] = tokpos[2 * (tk0 + q)]; tpv[q][1] = tokpos[2 * (tk0 + q) + 1]; }
                    __builtin_amdgcn_sched_barrier(0);
#pragma unroll
                    for (int q = 0; q < 4; ++q) { const int tp0 = tpv[q][0], tp1 = tpv[q][1]; int b0 = 0, b1 = 0;
#pragma unroll
                        for (int e = 0; e < 8; ++e) { if ((tp0 & 15) == e) b0 = tsv[e]; if ((tp1 & 15) == e) b1 = tsv[e]; }
                        s0[q] = (size_t)(b0 + (tp0 >> 4)) * D; s1[q] = (size_t)(b1 + (tp1 >> 4)) * D; }
#pragma unroll
                    for (int q = 0; q < 4; ++q) {
#pragma unroll
                      for (int j = 0; j < 2; ++j) { const int c = 8 * lane + 512 * j;
                        const u32x4 zz = {0u, 0u, 0u, 0u}; const size_t split0 = (size_t)128 * 256 * D;
                        const u32x4 y0 = ld_nt(Y + s0[q] + c), y1 = (s0[q] >= split0) ? ld_nt(Y + (size_t)SLOTS * D + s0[q] + c) : zz, y2 = ld_nt(Y + s1[q] + c), y3 = (s1[q] >= split0) ? ld_nt(Y + (size_t)SLOTS * D + s1[q] + c) : zz;
                        float* o = out + (size_t)(tk0 + q) * D + c;
#if RES_BF16
                        const u32x4 xr = ld_nt((const bf16_t*)(ws + WS_XB) + (size_t)(tk0 + q) * D + c); f32x4 a = {bf_lo(xr.x), bf_hi(xr.x), bf_lo(xr.y), bf_hi(xr.y)}, b = {bf_lo(xr.z), bf_hi(xr.z), bf_lo(xr.w), bf_hi(xr.w)};
#else
                        f32x4 a = *(const f32x4*)o, b = *(const f32x4*)(o + 4);
#endif
                        a.x += (bf_lo(y0.x) + bf_lo(y1.x)) + (bf_lo(y2.x) + bf_lo(y3.x)); a.y += (bf_hi(y0.x) + bf_hi(y1.x)) + (bf_hi(y2.x) + bf_hi(y3.x));
                        a.z += (bf_lo(y0.y) + bf_lo(y1.y)) + (bf_lo(y2.y) + bf_lo(y3.y)); a.w += (bf_hi(y0.y) + bf_hi(y1.y)) + (bf_hi(y2.y) + bf_hi(y3.y));
                        b.x += (bf_lo(y0.z) + bf_lo(y1.z)) + (bf_lo(y2.z) + bf_lo(y3.z)); b.y += (bf_hi(y0.z) + bf_hi(y1.z)) + (bf_hi(y2.z) + bf_hi(y3.z));
                        b.z += (bf_lo(y0.w) + bf_lo(y1.w)) + (bf_lo(y2.w) + bf_lo(y3.w)); b.w += (bf_hi(y0.w) + bf_hi(y1.w)) + (bf_hi(y2.w) + bf_hi(y3.w));
                        *(f32x4*)o = a; *(f32x4*)(o + 4) = b; } }
                }
            }
        }
    }
}

extern "C" void kernel_launch(void* const* d_in, const int* in_sizes, int n_in, void* d_out, int out_size, void* d_ws, size_t ws_size, hipStream_t stream) {
    static int grid = 0;
    if (grid == 0) {
        if (n_in != 23 || out_size != M * D || ws_size < WS_END) { fprintf(stderr, "kernel_launch: unexpected arguments (n_in %d out %d ws %zu)\n", n_in, out_size, ws_size); grid = -1; return; }
        int dev = 0, cus = 0, per_cu = 0;
        if (hipGetDevice(&dev) != hipSuccess || hipDeviceGetAttribute(&cus, hipDeviceAttributeMultiprocessorCount, dev) != hipSuccess) { grid = -1; return; }
        if (hipFuncSetAttribute((const void*)fwd_kernel, hipFuncAttributeMaxDynamicSharedMemorySize, LDS_BYTES) != hipSuccess) { fprintf(stderr, "kernel_launch: hipFuncSetAttribute failed\n"); grid = -1; return; }
        if (hipOccupancyMaxActiveBlocksPerMultiprocessor(&per_cu, (const void*)fwd_kernel, 512, LDS_BYTES) != hipSuccess || per_cu < 1) { fprintf(stderr, "kernel_launch: occupancy query says %d\n", per_cu); }
        (void)hipGetLastError();
        grid = cus;
    }
    if (grid < 0) return;
    (void)hipMemsetAsync((char*)d_ws + WS_CTL, 0, CTL_ZERO_BYTES, stream);
    Params p{};
    for (int i = 0; i < 23; ++i) p.in[i] = (const float*)d_in[i];
    p.out = (float*)d_out; p.ws = (unsigned char*)d_ws;
#if DBG_TWO
    p.mode = 1; hipLaunchKernelGGL(fwd_kernel, dim3(grid), dim3(512), LDS_BYTES, stream, p);
    (void)hipMemsetAsync((char*)d_ws + WS_CTL, 0, CTL_ZERO_BYTES, stream);
    p.mode = 2; hipLaunchKernelGGL(fwd_kernel, dim3(grid), dim3(512), LDS_BYTES, stream, p);
#else
    hipLaunchKernelGGL(fwd_kernel, dim3(grid), dim3(512), LDS_BYTES, stream, p);
#endif
}
```

```cpp
#include <hip/hip_runtime.h>
#include <cstdio>
#include <cstdint>
#include <type_traits>

#ifndef ACT8_WIDE
#define ACT8_WIDE 1
#endif
#ifndef RES_BF16
#define RES_BF16 1
#endif
#define LAS __attribute__((address_space(3)))
#define GAS __attribute__((address_space(1)))
typedef unsigned short bf16_t;
typedef short bf16x8 __attribute__((ext_vector_type(8)));
typedef short s16x4 __attribute__((ext_vector_type(4)));
typedef float f32x4 __attribute__((ext_vector_type(4)));
typedef float f32x2 __attribute__((ext_vector_type(2)));
typedef float f32x16 __attribute__((ext_vector_type(16)));
typedef unsigned u32x4 __attribute__((ext_vector_type(4)));
typedef unsigned u32x2 __attribute__((ext_vector_type(2)));
typedef GAS unsigned gu32;
typedef int v4i32 __attribute__((ext_vector_type(4)));
typedef int v8i32 __attribute__((ext_vector_type(8)));

constexpr int M = 16384, D = 1024, SEQ = 2048, NBATCH = 8, NH = 16, DQK = 96, DV = 64, QL = 512, KVL = 256, FF = 2816, NE = 8, DIN = 4896;
constexpr int N1 = 5120;
constexpr int NQ = 2048, NKV = 2048;
constexpr int SLOTS = 32768 + 2048;
constexpr float EPS = 1e-6f;
#ifndef MOE_FP8
#define MOE_FP8 1
#endif
constexpr int MESZ = MOE_FP8 ? 1 : 2;
constexpr float W8_SCALE = MOE_FP8 ? 64.0f : 1.0f;
constexpr float C2 = 0.10206207261596577f * 1.4426950408889634f;

constexpr size_t MiB = 1u << 20;
constexpr size_t WS_CTL = 0, CTL_ZERO_BYTES = 1 * MiB;
constexpr size_t WS_ROPE = 1 * MiB;
constexpr size_t WS_XSSP = WS_ROPE + 256 * 1024;
constexpr size_t WS_TOKPOS = WS_ROPE + 512 * 1024;
constexpr size_t WS_VSTP = 2 * MiB;
constexpr size_t WS_CQP = 4 * MiB;
constexpr size_t WS_CKVP = 4 * MiB + 512 * 1024;
constexpr size_t WS_KRSS = 4 * MiB + 768 * 1024;
constexpr size_t WS_KR = 5 * MiB;
constexpr size_t WS_IDXT = 7 * MiB;
constexpr size_t WS_IDXW = 7 * MiB + 512 * 1024;
constexpr size_t WS_WL = 8 * MiB, WL_STRIDE = 19 * MiB;
constexpr size_t WL_W1T = 0, WL_WUQ = 10 * MiB, WL_WUKV = 12 * MiB, WL_PA = 13 * MiB, WL_PB = 15 * MiB, WL_WOUT = 17 * MiB;
constexpr size_t WS_WGU = 46 * MiB;
constexpr size_t WS_WD = 57 * MiB;
constexpr size_t WS_MGU = 63 * MiB;
constexpr size_t WS_MD = 151 * MiB;
constexpr size_t WS_XB = 195 * MiB;
constexpr size_t WS_X2 = 227 * MiB;
constexpr size_t WS_U = 291 * MiB, WS_VG = 323 * MiB, WS_G = 355 * MiB, WS_Q = 419 * MiB, WS_KT = 467 * MiB, WS_VT = 515 * MiB;
constexpr size_t WS_AO = 547 * MiB, WS_O = 579 * MiB, WS_CQ = 611 * MiB, WS_CKV = 627 * MiB, WS_IDXR = 635 * MiB  , WS_END = 636 * MiB;
constexpr int AOO_LD = 2048;
constexpr size_t WS_T = WS_U;
constexpr size_t WS_MG = WS_Q;
constexpr size_t WS_X1 = WS_G;
constexpr size_t WS_ACT = WS_Q;
constexpr size_t WS_ACT2 = WS_U;
static_assert(WS_ACT + (size_t)M * FF * 2 <= WS_AO, "ACT overlay");
static_assert(WS_ACT2 + (size_t)SLOTS * FF * 2 <= WS_VT, "ACT2 overlay");
constexpr size_t WS_XB8 = 616 * MiB;
constexpr size_t WS_Y = 480 * MiB;
static_assert(WS_ACT2 + (size_t)SLOTS * FF * 2 <= WS_Y && WS_Y + (size_t)2 * SLOTS * D * 2 <= WS_END, "Y overlay");
constexpr int CW_BAR = 4096, CW_CNT = 16384  , CW_DBG = 32768;

constexpr int RING_BYTES = 131072;
constexpr int XCH_OFF = RING_BYTES;
constexpr int MISC_OFF = RING_BYTES + 4096;
constexpr int LDS_BYTES = 147456;

typedef __bf16 bf16x2_t __attribute__((ext_vector_type(2)));
__device__ __forceinline__ unsigned cvt_pk_bf16(float lo, float hi) { f32x2 v = {lo, hi}; bf16x2_t b = __builtin_convertvector(v, bf16x2_t); return __builtin_bit_cast(unsigned, b); }
__device__ __forceinline__ float bf_lo(unsigned u) { return __uint_as_float(u << 16); }
__device__ __forceinline__ float bf_hi(unsigned u) { return __uint_as_float(u & 0xffff0000u); }
__device__ __forceinline__ float bf1(bf16_t b) { return __uint_as_float(((unsigned)b) << 16); }
__device__ __forceinline__ float fexp2(float x) { return __builtin_amdgcn_exp2f(x); }
__device__ __forceinline__ float frcp(float x) { return __builtin_amdgcn_rcpf(x); }
__device__ __forceinline__ float frsq(float x) { return __builtin_amdgcn_rsqf(x); }
__device__ __forceinline__ float gelu_t(float v) { return v * frcp(1.0f + fexp2(-2.3022082f * v * (1.0f + 0.044715f * v * v))); }
__device__ __forceinline__ float sigm(float v) { return frcp(1.0f + fexp2(-1.4426950409f * v)); }
__device__ __forceinline__ f32x2 sigm2(f32x2 v) { const f32x2 t = v * (-1.4426950409f); f32x2 e; e.x = fexp2(t.x); e.y = fexp2(t.y); const f32x2 d = e + 1.0f; f32x2 r; r.x = frcp(d.x); r.y = frcp(d.y); return r; }
__device__ __forceinline__ f32x2 gelu2(f32x2 v) { const f32x2 u = v * (v * v * 0.044715f + 1.0f); return v * sigm2(u * 1.5957691216f); }
__device__ __forceinline__ f32x4 gelu4(f32x4 a) { const f32x2 lo = gelu2((f32x2){a.x, a.y}), hi = gelu2((f32x2){a.z, a.w}); return (f32x4){lo.x, lo.y, hi.x, hi.y}; }
__device__ __forceinline__ f32x4 sigm4(f32x4 a) { const f32x2 lo = sigm2((f32x2){a.x, a.y}), hi = sigm2((f32x2){a.z, a.w}); return (f32x4){lo.x, lo.y, hi.x, hi.y}; }
__device__ __forceinline__ int crow(int r, int hi) { return (r & 3) + 8 * (r >> 2) + 4 * hi; }
#define LDS_WAIT() asm volatile("s_waitcnt lgkmcnt(0)" ::: "memory")
#define VM_WAIT() asm volatile("s_waitcnt vmcnt(0)" ::: "memory")
#define RAW_BAR() do { asm volatile("" ::: "memory"); __builtin_amdgcn_s_barrier(); asm volatile("" ::: "memory"); } while (0)

namespace pg8 {
constexpr int BM = 256, BK = 64, HALF = 128, HTB = HALF * BK * 2, STAGE_BYTES = 8 * HTB, NXCD = 8, WGM = 8;
__host__ __device__ __forceinline__ int lds_byte(int r, int c) { const int st = (r >> 4) * 2 + (c >> 5), rr = r & 15, cc = c & 31, ob = rr * 64 + cc * 2; return st * 1024 + (ob ^ (((ob >> 9) & 1) << 5)); }
__host__ __device__ __forceinline__ void stage_rc(int b, int& R, int& C) { const int st = b / 1024, sb = b % 1024, swz = sb ^ (((sb >> 9) & 1) << 5); R = (st >> 1) * 16 + swz / 64; C = (st & 1) * 32 + (swz % 64) / 2; }
__host__ __device__ __forceinline__ int perm32(int rho) { const int n = rho >> 4, i = rho & 15; return 8 * (i >> 2) + 4 * n + (i & 3); }
struct Unit { int pm, pn, e, p0, cn, nt; };
struct StaticOrder {
    int nM, nN, nwg, G, c;
    __device__ __forceinline__ void init(int nM_, int nN_, int G_, int c_) { nM = nM_; nN = nN_; nwg = nM * nN; G = G_; c = c_; }
    __device__ __forceinline__ bool next(int i, Unit& u) const {
        const long L = (long)i * G + c; if (L >= nwg) return false;
        int wgid = (int)L; { const int q = nwg / NXCD, r = nwg % NXCD, xcd = wgid % NXCD, off = wgid / NXCD; wgid = (xcd < r ? xcd * (q + 1) : r * (q + 1) + (xcd - r) * q) + off; }
        const int nig = WGM * nN, gid = wgid / nig, fm = gid * WGM, gsz = (nM - fm) < WGM ? (nM - fm) : WGM;
        u.pm = fm + ((wgid % nig) % gsz); u.pn = (wgid % nig) / gsz; u.e = 0; u.p0 = 0; u.cn = 0; u.nt = 0; return true;
    }
};
template <class T, class = void> struct HasMid : std::false_type {};
template <class T> struct HasMid<T, std::void_t<decltype(&T::mid)>> : std::true_type {};
constexpr int UT_OFF = MISC_OFF + 4096, UT_N = 32;
typedef int i32x4u __attribute__((ext_vector_type(4)));
template <class Sched> __device__ __forceinline__ void unit_table_build(LAS unsigned char* lds, const Sched& S) {
    int tid = threadIdx.x; asm volatile("" : "+v"(tid));
    if (tid < UT_N) { int z = 0; asm volatile("" : "+v"(z));
        Unit u; u.pm = z - 1; u.pn = z; u.e = z; u.p0 = z; u.cn = z; u.nt = z; const bool ok = S.next(tid, u); if (!ok) u.pm = z - 1;
        *(LAS i32x4u*)(lds + UT_OFF + 32 * tid) = (i32x4u){u.pm, u.pn, u.e, u.p0}; *(LAS int*)(lds + UT_OFF + 32 * tid + 16) = u.cn; *(LAS int*)(lds + UT_OFF + 32 * tid + 20) = u.nt; }
    asm volatile("s_waitcnt lgkmcnt(0)" ::: "memory"); __builtin_amdgcn_s_barrier(); asm volatile("" ::: "memory");
}
__device__ __forceinline__ bool unit_get(LAS unsigned char* lds, int i, Unit& u) {
    if (i >= UT_N) return false;
    int o_ = UT_OFF + 32 * i; asm volatile("" : "+s"(o_));
    const i32x4u a = *(const LAS i32x4u*)(lds + o_); const int b0 = *(const LAS int*)(lds + o_ + 16), b1 = *(const LAS int*)(lds + o_ + 20);
    u.pm = __builtin_amdgcn_readfirstlane(a.x); u.pn = __builtin_amdgcn_readfirstlane(a.y); u.e = __builtin_amdgcn_readfirstlane(a.z); u.p0 = __builtin_amdgcn_readfirstlane(a.w);
    u.cn = __builtin_amdgcn_readfirstlane(b0); u.nt = __builtin_amdgcn_readfirstlane(b1); return u.pm >= 0;
}
template <class Epi, class Sched, bool ALIGN_EPI, bool GATHER>
__device__ __forceinline__ void gemm_phase(LAS unsigned char* lds, const int K, const int lda, const int ldb, const Sched& S, const Epi& E) {
    int tid = threadIdx.x; asm volatile("" : "+v"(tid));
    const int wid = __builtin_amdgcn_readfirstlane(tid >> 6), lane = tid & 63, wr = wid >> 2, wc = wid & 3, fr = lane & 15, fq = lane >> 4;
    int nt = K / BK; asm volatile("" : "+s"(nt));
    int Rr[2], Cc[2]; unsigned voffB[2];
#pragma unroll
    for (int i = 0; i < 2; ++i) { stage_rc(tid * 16 + i * 8192, Rr[i], Cc[i]); const int Rb = (Rr[i] & ~31) + perm32(Rr[i] & 31); voffB[i] = (unsigned)(Rb * ldb + Cc[i]) * 2u; }
    const size_t kstep = (size_t)(BK * 2);
    const size_t hstepB = (size_t)HALF * ldb * 2;
    const unsigned ldsw = (unsigned)wid * 1024u;
    const int aoff = lds_byte(wr * 64 + fr, fq * 8), boff = lds_byte(wc * 32 + fr, fq * 8);
#define PG8_SA(b, h) (((b) * 2 + (h)) * HTB)
#define PG8_SB(b, h) ((4 + (b) * 2 + (h)) * HTB)
#define PG8_STAGE(bufoff, gbase, voff) do { _Pragma("unroll") for (int _i = 0; _i < 2; ++_i) \
        __builtin_amdgcn_global_load_lds((const unsigned*)((const char*)(gbase) + (voff)[_i]), (LAS unsigned*)(lds + (bufoff) + ldsw + _i * 8192), 16, 0, 0); } while (0)
#define PG8_LDA(dst, b, h) do { _Pragma("unroll") for (int m = 0; m < 4; ++m) _Pragma("unroll") for (int k = 0; k < 2; ++k) dst[m][k] = *(const LAS bf16x8*)(lds + PG8_SA(b, h) + aoff + m * 2048 + k * 1024); } while (0)
#define PG8_LDB(dst, b, h) do { _Pragma("unroll") for (int n = 0; n < 2; ++n) _Pragma("unroll") for (int k = 0; k < 2; ++k) dst[n][k] = *(const LAS bf16x8*)(lds + PG8_SB(b, h) + boff + n * 2048 + k * 1024); } while (0)
#define PG8_MMA(ai, bj, At, Bt) do { __builtin_amdgcn_s_setprio(1); _Pragma("unroll") for (int m = 0; m < 4; ++m) _Pragma("unroll") for (int n = 0; n < 2; ++n) _Pragma("unroll") for (int k = 0; k < 2; ++k) \
        acc[ai][bj][m][n] = __builtin_amdgcn_mfma_f32_16x16x32_bf16(Bt[n][k], At[m][k], acc[ai][bj][m][n], 0, 0, 0); __builtin_amdgcn_s_setprio(0); } while (0)
#define PG8_WAIT_V(n) asm volatile("s_waitcnt vmcnt(" #n ")" ::: "memory")
#define PG8_WAIT_L(n) asm volatile("s_waitcnt lgkmcnt(" #n ")" ::: "memory")
#define PG8_BAR __builtin_amdgcn_s_barrier()
#define PG8_SCHED __builtin_amdgcn_sched_barrier(0)
#define PG8_SETVO(V, U_) do { _Pragma("unroll") for (int _h = 0; _h < 2; ++_h) _Pragma("unroll") for (int _i = 0; _i < 2; ++_i) { \
        const int _rl = _h * HALF + Rr[_i]; const int _row = GATHER ? S.tok(U_, _rl) : _rl; V[_h][_i] = (unsigned)(_row * lda + Cc[_i]) * 2u; } } while (0)
    Unit cur, nxt; int ui = 0;
    unit_table_build(lds, S);
    if (!unit_get(lds, 0, cur)) return;
    if (cur.nt > 0) { nt = cur.nt; asm volatile("" : "+s"(nt)); }
    f32x4 acc[2][2][4][2];
#pragma unroll
    for (int a = 0; a < 2; ++a)
#pragma unroll
        for (int b = 0; b < 2; ++b)
#pragma unroll
            for (int m = 0; m < 4; ++m)
#pragma unroll
                for (int n = 0; n < 2; ++n) acc[a][b][m][n] = (f32x4){0.f, 0.f, 0.f, 0.f};
    bf16x8 At[4][2], B0[2][2], B1[2][2];
    unsigned vo[2][2], nvo[2][2];
    PG8_SETVO(vo, cur);
#pragma unroll
    for (int h = 0; h < 2; ++h)
#pragma unroll
        for (int i = 0; i < 2; ++i) nvo[h][i] = vo[h][i];
    const char* cA = S.abase(cur); const char* cB = S.bbase(cur);
    PG8_STAGE(PG8_SB(0, 0), cB, voffB); PG8_STAGE(PG8_SB(0, 1), cB + hstepB, voffB); PG8_STAGE(PG8_SA(0, 0), cA, vo[0]); PG8_STAGE(PG8_SA(0, 1), cA, vo[1]);
    if (wr == 1) PG8_BAR;
    PG8_WAIT_V(2); PG8_BAR;
    PG8_STAGE(PG8_SB(1, 0), cB + kstep, voffB); PG8_STAGE(PG8_SA(1, 0), cA + kstep, vo[0]); PG8_STAGE(PG8_SB(1, 1), cB + hstepB + kstep, voffB);
    PG8_WAIT_V(6); PG8_BAR;
    for (;;) {
        const bool has_next = unit_get(lds, ui + 1, nxt);
        const char* nA = has_next ? S.abase(nxt) : cA; const char* nB = has_next ? S.bbase(nxt) : cB;
        if (GATHER) { if (has_next) PG8_SETVO(nvo, nxt); }
        for (int t = 0; t < nt; t += 2) {
            if constexpr (HasMid<Epi>::value) { if (t == (nt >> 1)) { asm volatile("" ::: "memory"); E.mid(acc, cur, wr, wc, fr, fq); asm volatile("" ::: "memory"); } }
            const bool last = (t == nt - 2);
            const char* a1 = cA + (size_t)(t + 1) * kstep;
            const char* a2 = last ? nA : cA + (size_t)(t + 2) * kstep; const char* b2 = last ? nB : cB + (size_t)(t + 2) * kstep;
            const char* a3 = a2 + kstep; const char* b3 = b2 + kstep;
            unsigned v2[2][2];
#pragma unroll
            for (int h = 0; h < 2; ++h)
#pragma unroll
                for (int i = 0; i < 2; ++i) v2[h][i] = GATHER ? (last ? nvo[h][i] : vo[h][i]) : vo[h][i];
            PG8_LDB(B0, 0, 0); PG8_LDB(B1, 0, 1); PG8_SCHED; PG8_LDA(At, 0, 0); PG8_STAGE(PG8_SA(1, 1), a1, vo[1]);
            PG8_WAIT_V(8); PG8_WAIT_L(0); PG8_BAR; PG8_MMA(0, 0, At, B0); PG8_MMA(0, 1, At, B1); PG8_BAR; PG8_SCHED;
            PG8_LDA(At, 0, 1); PG8_STAGE(PG8_SB(0, 0), b2, voffB); PG8_STAGE(PG8_SB(0, 1), b2 + hstepB, voffB); PG8_STAGE(PG8_SA(0, 0), a2, v2[0]);
            PG8_WAIT_V(8); PG8_WAIT_L(0); PG8_BAR; PG8_MMA(1, 0, At, B0); PG8_MMA(1, 1, At, B1); PG8_BAR; PG8_SCHED;
            PG8_LDB(B0, 1, 0); PG8_LDB(B1, 1, 1); PG8_SCHED; PG8_LDA(At, 1, 0); PG8_STAGE(PG8_SA(0, 1), a2, v2[1]);
            PG8_WAIT_V(8); PG8_WAIT_L(0); PG8_BAR; PG8_MMA(0, 0, At, B0); PG8_MMA(0, 1, At, B1); PG8_BAR; PG8_SCHED;
            PG8_LDA(At, 1, 1); PG8_STAGE(PG8_SB(1, 0), b3, voffB); PG8_STAGE(PG8_SB(1, 1), b3 + hstepB, voffB); PG8_STAGE(PG8_SA(1, 0), a3, v2[0]);
            PG8_WAIT_V(8); PG8_WAIT_L(0); PG8_BAR; PG8_MMA(1, 0, At, B0); PG8_MMA(1, 1, At, B1); PG8_BAR; PG8_SCHED;
        }
        if constexpr (ALIGN_EPI) { if (wr == 0) PG8_BAR; }
        asm volatile("" ::: "memory");
        if constexpr (!Epi::AFTER_DRAIN) { E(acc, cur, wr, wc, fr, fq, lds); }
        asm volatile("" ::: "memory");
        if (!has_next) break;
#pragma unroll
        for (int a = 0; a < 2; ++a)
#pragma unroll
            for (int b = 0; b < 2; ++b)
#pragma unroll
                for (int m = 0; m < 4; ++m)
#pragma unroll
                    for (int n = 0; n < 2; ++n) acc[a][b][m][n] = (f32x4){0.f, 0.f, 0.f, 0.f};
        cur = nxt; cA = nA; cB = nB; ++ui; if (cur.nt > 0) { nt = cur.nt; asm volatile("" : "+s"(nt)); }
        if (GATHER) {
#pragma unroll
            for (int h = 0; h < 2; ++h)
#pragma unroll
                for (int i = 0; i < 2; ++i) vo[h][i] = nvo[h][i];
        }
        if constexpr (ALIGN_EPI) { if (wr == 1) PG8_BAR; }
    }
    PG8_WAIT_V(0);
    if constexpr (!ALIGN_EPI) { if (wr == 0) PG8_BAR; }
    PG8_BAR;
    asm volatile("" ::: "memory");
    if constexpr (Epi::AFTER_DRAIN) { E.fused(acc, cur, wr, wc, fr, fq, lds, wid, lane); }
    asm volatile("" ::: "memory");
#undef PG8_SA
#undef PG8_SB
#undef PG8_STAGE
#undef PG8_LDA
#undef PG8_LDB
#undef PG8_MMA
#undef PG8_WAIT_V
#undef PG8_WAIT_L
#undef PG8_BAR
#undef PG8_SCHED
#undef PG8_SETVO
}
template <class Epi, class Sched, bool ALIGN_EPI, bool GATHER>
__device__ __forceinline__ void gemm_phase_f8(LAS unsigned char* lds, const int K, const int lda, const int ldb, const Sched& S, const Epi& E) {
    int tid = threadIdx.x; asm volatile("" : "+v"(tid));
    const int wid = __builtin_amdgcn_readfirstlane(tid >> 6), lane = tid & 63, wr = wid >> 2, wc = wid & 3, fr = lane & 15, fq = lane >> 4;
    int nt = K / (2 * BK); asm volatile("" : "+s"(nt));
    int Rr[2], Cc[2]; unsigned voffB[2];
#pragma unroll
    for (int i = 0; i < 2; ++i) { stage_rc(tid * 16 + i * 8192, Rr[i], Cc[i]); const int Rb = (Rr[i] & ~31) + perm32(Rr[i] & 31); voffB[i] = (unsigned)(Rb * ldb + Cc[i] * 2); }
    const size_t kstep = (size_t)(BK * 2);
    const size_t hstepB = (size_t)HALF * ldb;
    const unsigned ldsw = (unsigned)wid * 1024u;
    const int aoff = lds_byte(wr * 64 + fr, fq * 8), boff = lds_byte(wc * 32 + fr, fq * 8);
#define PG8_SA(b, h) (((b) * 2 + (h)) * HTB)
#define PG8_SB(b, h) ((4 + (b) * 2 + (h)) * HTB)
#define PG8_STAGE(bufoff, gbase, voff) do { _Pragma("unroll") for (int _i = 0; _i < 2; ++_i) \
        __builtin_amdgcn_global_load_lds((const unsigned*)((const char*)(gbase) + (voff)[_i]), (LAS unsigned*)(lds + (bufoff) + ldsw + _i * 8192), 16, 0, 0); } while (0)
#define PG8_LD16(off) (*(const LAS bf16x8*)(lds + (off)))
#define PG8_CAT8(lo, hi) __builtin_shufflevector(__builtin_bit_cast(v4i32, lo), __builtin_bit_cast(v4i32, hi), 0, 1, 2, 3, 4, 5, 6, 7)
#define PG8_LDA(dst, b, h) do { _Pragma("unroll") for (int m = 0; m < 4; ++m) dst[m] = PG8_CAT8(PG8_LD16(PG8_SA(b, h) + aoff + m * 2048), PG8_LD16(PG8_SA(b, h) + aoff + m * 2048 + 1024)); } while (0)
#define PG8_LDB(dst, b, h) do { _Pragma("unroll") for (int n = 0; n < 2; ++n) dst[n] = PG8_CAT8(PG8_LD16(PG8_SB(b, h) + boff + n * 2048), PG8_LD16(PG8_SB(b, h) + boff + n * 2048 + 1024)); } while (0)
#define PG8_MMA(ai, bj, At, Bt) do { __builtin_amdgcn_s_setprio(1); asm volatile("s_nop 1"); _Pragma("unroll") for (int m = 0; m < 4; ++m) _Pragma("unroll") for (int n = 0; n < 2; ++n) \
        asm volatile("v_mfma_f32_16x16x128_f8f6f4 %0, %1, %2, %0" : "+v"(acc[ai][bj][m][n]) : "v"(Bt[n]), "v"(At[m])); __builtin_amdgcn_s_setprio(0); } while (0)
#define PG8_WAIT_V(n) asm volatile("s_waitcnt vmcnt(" #n ")" ::: "memory")
#define PG8_WAIT_L(n) asm volatile("s_waitcnt lgkmcnt(" #n ")" ::: "memory")
#define PG8_BAR __builtin_amdgcn_s_barrier()
#define PG8_SCHED __builtin_amdgcn_sched_barrier(0)
#define PG8_SETVO(V, U_) do { int _row4[4]; if constexpr (GATHER) S.tok4(U_, Rr[0], Rr[1], _row4); \
        _Pragma("unroll") for (int _h = 0; _h < 2; ++_h) _Pragma("unroll") for (int _i = 0; _i < 2; ++_i) { \
        const int _rl = _h * HALF + Rr[_i]; const int _row = GATHER ? _row4[2 * _h + _i] : _rl; V[_h][_i] = (unsigned)(_row * lda + Cc[_i] * 2); } } while (0)
    Unit cur, nxt; int ui = 0;
    unit_table_build(lds, S);
    if (!unit_get(lds, 0, cur)) return;
    if (cur.nt > 0) { nt = cur.nt; asm volatile("" : "+s"(nt)); }
    f32x4 acc[2][2][4][2];
#pragma unroll
    for (int a = 0; a < 2; ++a)
#pragma unroll
        for (int b = 0; b < 2; ++b)
#pragma unroll
            for (int m = 0; m < 4; ++m)
#pragma unroll
                for (int n = 0; n < 2; ++n) acc[a][b][m][n] = (f32x4){0.f, 0.f, 0.f, 0.f};
    v8i32 At[4], B0[2], B1[2];
    unsigned vo[2][2], nvo[2][2];
    PG8_SETVO(vo, cur);
#pragma unroll
    for (int h = 0; h < 2; ++h)
#pragma unroll
        for (int i = 0; i < 2; ++i) nvo[h][i] = vo[h][i];
    const char* cA = S.abase(cur); const char* cB = S.bbase(cur);
    PG8_STAGE(PG8_SB(0, 0), cB, voffB); PG8_STAGE(PG8_SB(0, 1), cB + hstepB, voffB); PG8_STAGE(PG8_SA(0, 0), cA, vo[0]); PG8_STAGE(PG8_SA(0, 1), cA, vo[1]);
    if (wr == 1) PG8_BAR;
    PG8_WAIT_V(2); PG8_BAR;
    PG8_STAGE(PG8_SB(1, 0), cB + kstep, voffB); PG8_STAGE(PG8_SA(1, 0), cA + kstep, vo[0]); PG8_STAGE(PG8_SB(1, 1), cB + hstepB + kstep, voffB);
    PG8_WAIT_V(6); PG8_BAR;
    for (;;) {
        const bool has_next = unit_get(lds, ui + 1, nxt);
        const char* nA = has_next ? S.abase(nxt) : cA; const char* nB = has_next ? S.bbase(nxt) : cB;
        if (GATHER) { if (has_next) PG8_SETVO(nvo, nxt); }
        for (int t = 0; t < nt; t += 2) {
            if constexpr (HasMid<Epi>::value) { if (t == (nt >> 1)) { asm volatile("" ::: "memory"); E.mid(acc, cur, wr, wc, fr, fq); asm volatile("" ::: "memory"); } }
            const bool last = (t == nt - 2);
            const char* a1 = cA + (size_t)(t + 1) * kstep;
            const char* a2 = last ? nA : cA + (size_t)(t + 2) * kstep; const char* b2 = last ? nB : cB + (size_t)(t + 2) * kstep;
            const char* a3 = a2 + kstep; const char* b3 = b2 + kstep;
            unsigned v2[2][2];
#pragma unroll
            for (int h = 0; h < 2; ++h)
#pragma unroll
                for (int i = 0; i < 2; ++i) v2[h][i] = GATHER ? (last ? nvo[h][i] : vo[h][i]) : vo[h][i];
            PG8_LDB(B0, 0, 0); PG8_LDB(B1, 0, 1); PG8_SCHED; PG8_LDA(At, 0, 0); PG8_STAGE(PG8_SA(1, 1), a1, vo[1]);
            PG8_WAIT_V(8); PG8_WAIT_L(0); PG8_BAR; PG8_MMA(0, 0, At, B0); PG8_MMA(0, 1, At, B1); PG8_BAR; PG8_SCHED;
            PG8_LDA(At, 0, 1); PG8_STAGE(PG8_SB(0, 0), b2, voffB); PG8_STAGE(PG8_SB(0, 1), b2 + hstepB, voffB); PG8_STAGE(PG8_SA(0, 0), a2, v2[0]);
            PG8_WAIT_V(8); PG8_WAIT_L(0); PG8_BAR; PG8_MMA(1, 0, At, B0); PG8_MMA(1, 1, At, B1); PG8_BAR; PG8_SCHED;
            PG8_LDB(B0, 1, 0); PG8_LDB(B1, 1, 1); PG8_SCHED; PG8_LDA(At, 1, 0); PG8_STAGE(PG8_SA(0, 1), a2, v2[1]);
            PG8_WAIT_V(8); PG8_WAIT_L(0); PG8_BAR; PG8_MMA(0, 0, At, B0); PG8_MMA(0, 1, At, B1); PG8_BAR; PG8_SCHED;
            PG8_LDA(At, 1, 1); PG8_STAGE(PG8_SB(1, 0), b3, voffB); PG8_STAGE(PG8_SB(1, 1), b3 + hstepB, voffB); PG8_STAGE(PG8_SA(1, 0), a3, v2[0]);
            PG8_WAIT_V(8); PG8_WAIT_L(0); PG8_BAR; PG8_MMA(1, 0, At, B0); PG8_MMA(1, 1, At, B1); PG8_BAR; PG8_SCHED;
        }
        if constexpr (ALIGN_EPI) { if (wr == 0) PG8_BAR; }
        asm volatile("s_nop 15\n\ts_nop 15" : "+v"(acc[0][0][0][0]), "+v"(acc[0][0][0][1]), "+v"(acc[0][0][1][0]), "+v"(acc[0][0][1][1]), "+v"(acc[0][0][2][0]), "+v"(acc[0][0][2][1]), "+v"(acc[0][0][3][0]), "+v"(acc[0][0][3][1]), "+v"(acc[0][1][0][0]), "+v"(acc[0][1][0][1]), "+v"(acc[0][1][1][0]), "+v"(acc[0][1][1][1]), "+v"(acc[0][1][2][0]), "+v"(acc[0][1][2][1]), "+v"(acc[0][1][3][0]), "+v"(acc[0][1][3][1]) :: "memory");
        asm volatile("" : "+v"(acc[1][0][0][0]), "+v"(acc[1][0][0][1]), "+v"(acc[1][0][1][0]), "+v"(acc[1][0][1][1]), "+v"(acc[1][0][2][0]), "+v"(acc[1][0][2][1]), "+v"(acc[1][0][3][0]), "+v"(acc[1][0][3][1]), "+v"(acc[1][1][0][0]), "+v"(acc[1][1][0][1]), "+v"(acc[1][1][1][0]), "+v"(acc[1][1][1][1]), "+v"(acc[1][1][2][0]), "+v"(acc[1][1][2][1]), "+v"(acc[1][1][3][0]), "+v"(acc[1][1][3][1]) :: "memory");
        if constexpr (!Epi::AFTER_DRAIN) { E(acc, cur, wr, wc, fr, fq, lds); }
        asm volatile("" ::: "memory");
        if (!has_next) break;
#pragma unroll
        for (int a = 0; a < 2; ++a)
#pragma unroll
            for (int b = 0; b < 2; ++b)
#pragma unroll
                for (int m = 0; m < 4; ++m)
#pragma unroll
                    for (int n = 0; n < 2; ++n) acc[a][b][m][n] = (f32x4){0.f, 0.f, 0.f, 0.f};
        cur = nxt; cA = nA; cB = nB; ++ui; if (cur.nt > 0) { nt = cur.nt; asm volatile("" : "+s"(nt)); }
        if (GATHER) {
#pragma unroll
            for (int h = 0; h < 2; ++h)
#pragma unroll
                for (int i = 0; i < 2; ++i) vo[h][i] = nvo[h][i];
        }
        if constexpr (ALIGN_EPI) { if (wr == 1) PG8_BAR; }
    }
    PG8_WAIT_V(0);
    if constexpr (!ALIGN_EPI) { if (wr == 0) PG8_BAR; }
    PG8_BAR;
    asm volatile("" ::: "memory");
    if constexpr (Epi::AFTER_DRAIN) { E.fused(acc, cur, wr, wc, fr, fq, lds, wid, lane); }
    asm volatile("" ::: "memory");
#undef PG8_SA
#undef PG8_SB
#undef PG8_STAGE
#undef PG8_LDA
#undef PG8_LD16
#undef PG8_CAT8
#undef PG8_LDB
#undef PG8_MMA
#undef PG8_WAIT_V
#undef PG8_WAIT_L
#undef PG8_BAR
#undef PG8_SCHED
#undef PG8_SETVO
}
}
using pg8::Unit;

struct SchedStd : pg8::StaticOrder {
    const char* A; const char* Bt; size_t astep, bstep;
    __device__ __forceinline__ const char* abase(const Unit& u) const { return A + (size_t)u.pm * astep; }
    __device__ __forceinline__ const char* bbase(const Unit& u) const { return Bt + (size_t)u.pn * bstep; }
    __device__ __forceinline__ int tok(const Unit&, int rl) const { return rl; }
};
__device__ __forceinline__ int moe_cnt(const unsigned* cntw, int e) { return (int)__builtin_amdgcn_readfirstlane((int)__hip_atomic_load(cntw + 64 * e, __ATOMIC_RELAXED, __HIP_MEMORY_SCOPE_AGENT)); }
__device__ __forceinline__ int moe_total_tiles(const unsigned* cntw) { int t = 0;
#pragma unroll
    for (int e = 0; e < 8; ++e) t += (moe_cnt(cntw, e) + 255) >> 8; return t; }
constexpr int MOE_TT_OFF = MISC_OFF + 1024, MOE_TT_N = 160;
typedef int i32x4 __attribute__((ext_vector_type(4)));
__device__ __forceinline__ void moe_table_build(LAS unsigned char* lds, const unsigned* cntw) {
    int tid = threadIdx.x; asm volatile("" : "+v"(tid));
    if (tid <= MOE_TT_N) { int c[8];
#pragma unroll
        for (int j = 0; j < 8; ++j) c[j] = (int)__hip_atomic_load(cntw + 64 * j, __ATOMIC_RELAXED, __HIP_MEMORY_SCOPE_AGENT);
        int acc = 0, e = 0, tse = 0, cn = 1;
#pragma unroll
        for (int j = 0; j < 8; ++j) { if (tid >= acc) { e = j; tse = acc; cn = c[j]; } acc += (c[j] + 255) >> 8; }
        *(LAS i32x4*)(lds + MOE_TT_OFF + 16 * tid) = (tid < MOE_TT_N) ? (i32x4){e, (tid - tse) * 256, cn, 0} : (i32x4){acc, 0, 0, 0}; }
    __syncthreads();
}
__device__ __forceinline__ int moe_table_tiles(LAS unsigned char* lds) { return __builtin_amdgcn_readfirstlane(*(const LAS int*)(lds + MOE_TT_OFF + 16 * MOE_TT_N)); }
__device__ __forceinline__ void moe_fill(LAS const unsigned char* tt, Unit& u) { const i32x4 v = *(const LAS i32x4*)(tt + 16 * u.pm); u.e = v.x; u.p0 = v.y; u.cn = v.z; }
struct SchedMoeGu : pg8::StaticOrder {
    const char* XB; const char* W; LAS const unsigned char* tt; const int* idxt;
    __device__ __forceinline__ bool next(int i, Unit& u) const { if (!pg8::StaticOrder::next(i, u)) return false; moe_fill(tt, u); return true; }
    __device__ __forceinline__ const char* abase(const Unit&) const { return XB; }
    __device__ __forceinline__ const char* bbase(const Unit& u) const { return W + (size_t)u.e * ((size_t)2 * FF * D * MESZ) + (size_t)u.pn * (256 * D * MESZ); }
    __device__ __forceinline__ int tok(const Unit& u, int rl) const { const int pos = u.p0 + rl; return idxt[u.e * M + (pos < u.cn ? pos : u.cn - 1)]; }
    __device__ __forceinline__ void tok4(const Unit& u, int r0, int r1, int (&out)[4]) const {
        const int* base = idxt + u.e * M; const int lim = u.cn - 1;
        int p[4] = {u.p0 + r0, u.p0 + r1, u.p0 + 128 + r0, u.p0 + 128 + r1};
#pragma unroll
        for (int i = 0; i < 4; ++i) p[i] = (p[i] < lim ? p[i] : lim) * 4;
        asm volatile("global_load_dword %0, %4, %8\n\tglobal_load_dword %1, %5, %8\n\tglobal_load_dword %2, %6, %8\n\tglobal_load_dword %3, %7, %8\n\ts_waitcnt vmcnt(0)"
                     : "=&v"(out[0]), "=&v"(out[1]), "=&v"(out[2]), "=&v"(out[3]) : "v"(p[0]), "v"(p[1]), "v"(p[2]), "v"(p[3]), "s"(base) : "memory");
    }
};
struct SchedMoeDn {
    const char* A; const char* W; LAS const unsigned char* tt; int RT, G, c;
    static constexpr int KTW = MOE_FP8 ? 22 : 44, KT0 = MOE_FP8 ? 10 : 22, KT1 = MOE_FP8 ? 12 : 22, RT0 = 128;
    __device__ __forceinline__ void init(int RT_, int G_, int c_) { RT = RT_; G = G_; c = c_; }
    __device__ __forceinline__ bool next(int i, Unit& u) const {
        const int L = i * G + c; const int nw = RT0 * 4;
        if (L < nw) { pg8::StaticOrder so; so.init(RT0, 4, G, c); if (!so.next(i, u)) return false; u.nt = KTW; }
        else { const int L2 = L - nw, n2 = (RT - RT0) * 8; if (L2 >= n2) return false;
            u.pm = RT0 + (L2 >> 3); u.pn = L2 & 7; u.nt = (u.pn >> 2) ? KT1 : KT0; }
        moe_fill(tt, u); return true;
    }
    __device__ __forceinline__ int kofs(const Unit& u) const { return (u.pm >= RT0 && (u.pn >> 2)) ? KT0 * 128 : 0; }
    __device__ __forceinline__ const char* abase(const Unit& u) const { return A + (size_t)u.pm * (256 * (size_t)FF * MESZ) + kofs(u); }
    __device__ __forceinline__ const char* bbase(const Unit& u) const { return W + (size_t)u.e * ((size_t)D * FF * MESZ) + (size_t)(u.pn & 3) * (256 * (size_t)FF * MESZ) + kofs(u); }
    __device__ __forceinline__ int tok(const Unit&, int rl) const { return rl; }
};

#define EPI_ROWS(ai, m) for (int ai = 0; ai < 2; ++ai) _Pragma("unroll") for (int m = 0; m < 4; ++m)
__device__ __forceinline__ float sum4(f32x4 v) { return (v.x + v.y) + (v.z + v.w); }
__device__ __forceinline__ float xsum16(float s) { return s + __uint_as_float((unsigned)__builtin_amdgcn_ds_swizzle((int)__float_as_uint(s), 0x401F)); }
__device__ __forceinline__ float xsum32(float s) { auto r = __builtin_amdgcn_permlane32_swap(__float_as_uint(s), __float_as_uint(s), false, false); return __uint_as_float(r[0]) + __uint_as_float(r[1]); }
__device__ __forceinline__ float xmax32(float s) { auto r = __builtin_amdgcn_permlane32_swap(__float_as_uint(s), __float_as_uint(s), false, false); return fmaxf(__uint_as_float(r[0]), __uint_as_float(r[1])); }
__device__ __forceinline__ float qsum(float s) { return xsum32(xsum16(s)); }
#define DPP_ROR_ADD(s, n) ((s) + __uint_as_float(__builtin_amdgcn_update_dpp(0u, __float_as_uint(s), 0x120 + (n), 0xf, 0xf, false)))
__device__ __forceinline__ float wave_sum(float s) { s = DPP_ROR_ADD(s, 8); s = DPP_ROR_ADD(s, 4); s = DPP_ROR_ADD(s, 2); s = DPP_ROR_ADD(s, 1); return xsum32(xsum16(s)); }
__device__ __forceinline__ u32x2 pack8_f8(f32x4 a, f32x4 b) { int w0 = 0, w1 = 0; w0 = __builtin_amdgcn_cvt_pk_fp8_f32(a.x, a.y, w0, false); w0 = __builtin_amdgcn_cvt_pk_fp8_f32(a.z, a.w, w0, true);
    w1 = __builtin_amdgcn_cvt_pk_fp8_f32(b.x, b.y, w1, false); w1 = __builtin_amdgcn_cvt_pk_fp8_f32(b.z, b.w, w1, true); return (u32x2){(unsigned)w0, (unsigned)w1}; }
__device__ __forceinline__ void st_wt(void* p, u32x4 v) { asm volatile("global_store_dwordx4 %0, %1, off sc1\n\ts_nop 1" :: "v"(p), "v"(v) : "memory"); }
__device__ __forceinline__ f32x4 ld_nt(const float* p) { return __builtin_nontemporal_load((const f32x4*)p); }
__device__ __forceinline__ u32x4 ld_nt(const bf16_t* p) { return __builtin_nontemporal_load((const u32x4*)p); }
__device__ __forceinline__ u32x4 pack8(f32x4 a, f32x4 b) { u32x4 w; w.x = cvt_pk_bf16(a.x, a.y); w.y = cvt_pk_bf16(a.z, a.w); w.z = cvt_pk_bf16(b.x, b.y); w.w = cvt_pk_bf16(b.z, b.w); return w; }

struct EpiG1 {
    static constexpr bool AFTER_DRAIN = false;
    const float* xssp; bf16_t *U, *Vg, *CQ, *CKV, *G; float *vstp, *cqp, *ckvp, *KR, *krss; const float* gk; const float *cosT, *sinT;
    __device__ __forceinline__ void operator()(f32x4 (&acc)[2][2][4][2], const Unit& u, int wr, int wc, int fr, int fq, LAS unsigned char*) const {
        int row0 = u.pm * 256 + wr * 64 + fr; asm volatile("" : "+v"(row0)); const int t = u.pn; const int pc = 32 * wc + 8 * fq;
        float rs[2][4]; { f32x4 xs_[2][4];
#pragma unroll
        EPI_ROWS(ai, m) { const int r = row0 + ai * 128 + m * 16; xs_[ai][m] = *(const f32x4*)(xssp + (size_t)r * 4); }
        __builtin_amdgcn_sched_barrier(0);
#pragma unroll
        EPI_ROWS(ai, m) rs[ai][m] = frsq(sum4(xs_[ai][m]) * (1.0f / D) + EPS); }
        if (t < 4) {
#pragma unroll
            EPI_ROWS(ai, m) { const int r = row0 + ai * 128 + m * 16; const float s = rs[ai][m];
#pragma unroll
                for (int bj = 0; bj < 2; ++bj) { f32x4 a = acc[ai][bj][m][0] * s, b = acc[ai][bj][m][1] * s;
                    a = gelu4(a); b = gelu4(b);
                    st_wt(U + (size_t)r * D + 256 * t + 128 * bj + pc, pack8(a, b)); } }
        } else if (t < 8) {
#pragma unroll
            EPI_ROWS(ai, m) { const int r = row0 + ai * 128 + m * 16; const float s = rs[ai][m]; float s1 = 0.f, s2 = 0.f;
#pragma unroll
                for (int bj = 0; bj < 2; ++bj) { f32x4 a = acc[ai][bj][m][0] * s, b = acc[ai][bj][m][1] * s;
                    a = gelu4(a); b = gelu4(b); s1 += sum4(a) + sum4(b); s2 += sum4(a * a) + sum4(b * b);
                    st_wt(Vg + (size_t)r * D + 256 * (t - 4) + 128 * bj + pc, pack8(a, b)); }
                s1 = qsum(s1); s2 = qsum(s2);
                if (fq == 0) *(f32x2*)(vstp + ((size_t)r * 16 + (t - 4) * 4 + wc) * 2) = (f32x2){s1, s2}; }
        } else if (t < 11) {
            bf16_t* O = (t < 10) ? CQ : CKV; const int ldo = (t < 10) ? QL : KVL; const int cb = (t < 10) ? 256 * (t - 8) : 0;
            float* pp = (t < 10) ? cqp : ckvp; const int np = (t < 10) ? 8 : 4; const int pi = (t < 10) ? (t - 8) * 4 + wc : wc;
#pragma unroll
            EPI_ROWS(ai, m) { const int r = row0 + ai * 128 + m * 16; const float s = rs[ai][m]; float s2 = 0.f;
#pragma unroll
                for (int bj = 0; bj < 2; ++bj) { f32x4 a = acc[ai][bj][m][0] * s, b = acc[ai][bj][m][1] * s;
#pragma unroll
                    for (int i = 0; i < 4; ++i) s2 += a[i] * a[i] + b[i] * b[i];
                    st_wt(O + (size_t)r * ldo + cb + 128 * bj + pc, pack8(a, b)); }
                s2 = qsum(s2);
                if (fq == 0) pp[(size_t)r * np + pi] = s2; }
        } else if (t == 11) {
            if (wc == 0) {
                const f32x4 g0 = *(const f32x4*)(gk + 64 + 4 * fq), g1 = *(const f32x4*)(gk + 80 + 4 * fq);
#pragma unroll
              for (int ai = 0; ai < 2; ++ai) { f32x4 cc_[4], ss_[4];
#pragma unroll
                for (int m = 0; m < 4; ++m) { const int pos = (row0 + ai * 128 + m * 16) & (SEQ - 1); cc_[m] = *(const f32x4*)(cosT + pos * 16 + 4 * fq); ss_[m] = *(const f32x4*)(sinT + pos * 16 + 4 * fq); }
                __builtin_amdgcn_sched_barrier(0);
#pragma unroll
                for (int m = 0; m < 4; ++m) { const int r = row0 + ai * 128 + m * 16; const float s = rs[ai][m];
                    const f32x4 a0 = acc[ai][0][m][0] * s, a1 = acc[ai][0][m][1] * s;
                    float s2 = sum4(a0 * a0) + sum4(a1 * a1); s2 = qsum(s2);
                    const f32x4 c = cc_[m], sn = ss_[m];
                    const f32x4 x0 = a0 * g0, x1 = a1 * g1;
                    *(f32x4*)(KR + (size_t)r * 32 + 4 * fq) = x0 * c - x1 * sn;
                    *(f32x4*)(KR + (size_t)r * 32 + 16 + 4 * fq) = x1 * c + x0 * sn;
                    if (fq == 0) krss[r] = s2; } }
            }
        } else {
#pragma unroll
            EPI_ROWS(ai, m) { const int r = row0 + ai * 128 + m * 16; const float s = rs[ai][m];
#pragma unroll
                for (int bj = 0; bj < 2; ++bj) { f32x4 a = acc[ai][bj][m][0] * s, b = acc[ai][bj][m][1] * s;
                    a = sigm4(a); b = sigm4(b);
                    st_wt(G + (size_t)r * 2048 + 256 * (t - 12) + 128 * bj + pc, pack8(a, b)); } }
        }
    }
};


struct EpiRaw {
    static constexpr bool AFTER_DRAIN = false;
    bf16_t* O; int ldc;
    __device__ __forceinline__ void operator()(f32x4 (&acc)[2][2][4][2], const Unit& u, int wr, int wc, int fr, int fq, LAS unsigned char*) const {
        int row0 = u.pm * 256 + wr * 64 + fr; asm volatile("" : "+v"(row0)); const int pc = 32 * wc + 8 * fq;
#pragma unroll
        EPI_ROWS(ai, m) { const int r = row0 + ai * 128 + m * 16;
#pragma unroll
            for (int bj = 0; bj < 2; ++bj) *(u32x4*)(O + (size_t)r * ldc + 256 * u.pn + 128 * bj + pc) = pack8(acc[ai][bj][m][0], acc[ai][bj][m][1]); }
    }
};

struct EpiQ {
    static constexpr bool AFTER_DRAIN = false;
    const float* cqp; const float* gq; const float *cosT, *sinT; bf16_t* Q;
    __device__ __forceinline__ void operator()(f32x4 (&acc)[2][2][4][2], const Unit& u, int wr, int wc, int fr, int fq, LAS unsigned char* lds) const {
        LAS float* P = (LAS float*)(lds + XCH_OFF); asm volatile("" : "+v"(fq));
        int row0 = u.pm * 256 + wr * 64 + fr; asm volatile("" : "+v"(row0)); const int head = 2 * u.pn + (wc >> 1), half = wc & 1;
        float ps[2][4], rsq_[2][4];
#pragma unroll
        for (int am = 0; am < 4; ++am) { const int ai = am >> 1; f32x4 c0_[2], c1_[2];
#pragma unroll
            for (int h_ = 0; h_ < 2; ++h_) { const int r = row0 + ai * 128 + (2 * (am & 1) + h_) * 16; c0_[h_] = *(const f32x4*)(cqp + (size_t)r * 8); c1_[h_] = *(const f32x4*)(cqp + (size_t)r * 8 + 4); }
            __builtin_amdgcn_sched_barrier(0);
#pragma unroll
            for (int h_ = 0; h_ < 2; ++h_) rsq_[ai][2 * (am & 1) + h_] = frsq((sum4(c0_[h_]) + sum4(c1_[h_])) * (1.0f / QL) + EPS); }
#pragma unroll
        EPI_ROWS(ai, m) {
            const float rs = rsq_[ai][m];
            f32x4 a = acc[ai][0][m][0] * rs, b = acc[ai][0][m][1] * rs; acc[ai][0][m][0] = a; acc[ai][0][m][1] = b;
            float s = sum4(a * a) + sum4(b * b);
            if (half == 0) { f32x4 c = acc[ai][1][m][0] * rs, d = acc[ai][1][m][1] * rs; acc[ai][1][m][0] = c; acc[ai][1][m][1] = d; s += sum4(c * c) + sum4(d * d); }
            s = qsum(s); ps[ai][m] = s;
            if (fq == 0) P[(ai * 128 + wr * 64 + m * 16 + fr) * 4 + wc] = s; }
        LDS_WAIT(); RAW_BAR();
        const f32x4 gn0 = *(const f32x4*)(gq + 32 * half + 8 * fq), gn1 = *(const f32x4*)(gq + 32 * half + 8 * fq + 4);
        const f32x4 gr0 = *(const f32x4*)(gq + 64 + 4 * fq), gr1 = *(const f32x4*)(gq + 80 + 4 * fq);
#pragma unroll
        for (int am = 0; am < 4; ++am) { const int ai = am >> 1; f32x4 cc_[2], ss_[2];
            if (half == 0) {
#pragma unroll
                for (int h_ = 0; h_ < 2; ++h_) { const int pos = (row0 + ai * 128 + (2 * (am & 1) + h_) * 16) & (SEQ - 1); cc_[h_] = *(const f32x4*)(cosT + pos * 16 + 4 * fq); ss_[h_] = *(const f32x4*)(sinT + pos * 16 + 4 * fq); }
            }
            __builtin_amdgcn_sched_barrier(0);
#pragma unroll
          for (int h_ = 0; h_ < 2; ++h_) { const int m = 2 * (am & 1) + h_; const int r = row0 + ai * 128 + m * 16; const int rl = ai * 128 + wr * 64 + m * 16 + fr;
            const float oth = P[rl * 4 + (wc ^ 1)];
            const float rstd = frsq((ps[ai][m] + oth) * (1.0f / DQK) + EPS) * C2;
            bf16_t* qrow = Q + (size_t)r * (NH * DQK) + head * DQK;
            *(u32x4*)(qrow + 32 * half + 8 * fq) = pack8(acc[ai][0][m][0] * gn0 * rstd, acc[ai][0][m][1] * gn1 * rstd);
            if (half == 0) {
                const f32x4 c = cc_[h_], sn = ss_[h_];
                const f32x4 x0 = acc[ai][1][m][0] * gr0, x1 = acc[ai][1][m][1] * gr1;
                const f32x4 o1 = (x0 * c - x1 * sn) * rstd, o2 = (x1 * c + x0 * sn) * rstd;
                *(u32x2*)(qrow + 64 + 4 * fq) = (u32x2){cvt_pk_bf16(o1.x, o1.y), cvt_pk_bf16(o1.z, o1.w)};
                *(u32x2*)(qrow + 80 + 4 * fq) = (u32x2){cvt_pk_bf16(o2.x, o2.y), cvt_pk_bf16(o2.z, o2.w)}; } } }
    }
};

struct EpiKV {
    static constexpr bool AFTER_DRAIN = false;
    const float* ckvp; const float* krss; const float* KR; const float* gk; bf16_t *Kt, *Vt;
    __device__ __forceinline__ void operator()(f32x4 (&acc)[2][2][4][2], const Unit& u, int wr, int wc, int fr, int fq, LAS unsigned char*) const {
        int row0 = u.pm * 256 + wr * 64 + fr; asm volatile("" : "+v"(row0)); const int head = 2 * u.pn + (wc >> 1), isv = wc & 1;
        asm volatile("" : "+v"(fq));
        float rsv[2][4], kss[2][4];
#pragma unroll
        for (int ai = 0; ai < 2; ++ai) { f32x4 xs_[4];
#pragma unroll
            for (int m = 0; m < 4; ++m) { const int r = row0 + ai * 128 + m * 16; xs_[m] = *(const f32x4*)(ckvp + (size_t)r * 4); kss[ai][m] = isv ? 0.f : krss[r]; }
            __builtin_amdgcn_sched_barrier(0);
#pragma unroll
            for (int m = 0; m < 4; ++m) rsv[ai][m] = frsq(sum4(xs_[m]) * (1.0f / KVL) + EPS);
            __builtin_amdgcn_sched_barrier(0); }
        f32x4 g[2][2];
#pragma unroll
        for (int bj = 0; bj < 2; ++bj) { g[bj][0] = *(const f32x4*)(gk + 32 * bj + 8 * fq); g[bj][1] = *(const f32x4*)(gk + 32 * bj + 8 * fq + 4); }
#pragma unroll
        EPI_ROWS(ai, m) { const int r = row0 + ai * 128 + m * 16; const int b = r >> 11, sq = r & (SEQ - 1), tile = sq >> 6, key = sq & 63;
            const float rs = rsv[ai][m];
            const size_t bht = (size_t)(b * NH + head) * 32 + tile;
            if (isv) {
#pragma unroll
                for (int bj = 0; bj < 2; ++bj) st_wt(Vt + (bht * 2 + bj) * 2048 + key * 32 + 8 * fq, pack8(acc[ai][bj][m][0] * rs, acc[ai][bj][m][1] * rs));
            } else {
                f32x4 v[2][2]; float s_ = 0.f;
#pragma unroll
                for (int bj = 0; bj < 2; ++bj)
#pragma unroll
                    for (int n = 0; n < 2; ++n) { v[bj][n] = acc[ai][bj][m][n] * rs; s_ += sum4(v[bj][n] * v[bj][n]); }
                s_ = qsum(s_) + kss[ai][m];
                const float rstd = frsq(s_ * (1.0f / DQK) + EPS);
#pragma unroll
                for (int bj = 0; bj < 2; ++bj) st_wt(Kt + (bht * 12 + 4 * bj + fq) * 512 + key * 8, pack8(v[bj][0] * g[bj][0] * rstd, v[bj][1] * g[bj][1] * rstd));
                const f32x4 k0 = *(const f32x4*)(KR + (size_t)r * 32 + 8 * fq), k1 = *(const f32x4*)(KR + (size_t)r * 32 + 8 * fq + 4);
                st_wt(Kt + (bht * 12 + 8 + fq) * 512 + key * 8, pack8(k0 * rstd, k1 * rstd));
            } }
    }
};

struct EpiProjF {
    static constexpr bool AFTER_DRAIN = false;
    const bf16_t* G; bf16_t* MG;
    __device__ __forceinline__ void mid(f32x4 (&acc)[2][2][4][2], const Unit& u, int wr, int wc, int fr, int fq) const {
        int row0 = u.pm * 256 + wr * 64 + fr; asm volatile("" : "+v"(row0)); const int col0 = u.pn * 256 + 32 * wc + 8 * fq;
#pragma unroll
        for (int ai = 0; ai < 2; ++ai) { u32x4 ga_[4][2], gb_[4][2];
#pragma unroll
            for (int m = 0; m < 4; ++m) { const int r = row0 + ai * 128 + m * 16;
#pragma unroll
                for (int bj = 0; bj < 2; ++bj) { const int c = col0 + 128 * bj; ga_[m][bj] = *(const u32x4*)(G + (size_t)r * 2048 + c); gb_[m][bj] = *(const u32x4*)(G + (size_t)r * 2048 + 1024 + c); } }
            __builtin_amdgcn_sched_barrier(0);
#pragma unroll
            for (int m = 0; m < 4; ++m)
#pragma unroll
                for (int bj = 0; bj < 2; ++bj) { const u32x4 ga = ga_[m][bj], gb = gb_[m][bj];
                    const f32x4 r0 = {bf_lo(ga.x) * frcp(bf_lo(gb.x)), bf_hi(ga.x) * frcp(bf_hi(gb.x)), bf_lo(ga.y) * frcp(bf_lo(gb.y)), bf_hi(ga.y) * frcp(bf_hi(gb.y))};
                    const f32x4 r1 = {bf_lo(ga.z) * frcp(bf_lo(gb.z)), bf_hi(ga.z) * frcp(bf_hi(gb.z)), bf_lo(ga.w) * frcp(bf_lo(gb.w)), bf_hi(ga.w) * frcp(bf_hi(gb.w))};
                    acc[ai][bj][m][0] = acc[ai][bj][m][0] * r0; acc[ai][bj][m][1] = acc[ai][bj][m][1] * r1; }
            __builtin_amdgcn_sched_barrier(0); }
    }
    __device__ __forceinline__ void operator()(f32x4 (&acc)[2][2][4][2], const Unit& u, int wr, int wc, int fr, int fq, LAS unsigned char*) const {
        int row0 = u.pm * 256 + wr * 64 + fr; asm volatile("" : "+v"(row0)); const int col0 = u.pn * 256 + 32 * wc + 8 * fq;
        u32x4 gb_[2][4][2];
#pragma unroll
        EPI_ROWS(ai, m) { const int r = row0 + ai * 128 + m * 16;
#pragma unroll
            for (int bj = 0; bj < 2; ++bj) gb_[ai][m][bj] = *(const u32x4*)(G + (size_t)r * 2048 + 1024 + col0 + 128 * bj); }
        __builtin_amdgcn_sched_barrier(0);
#pragma unroll
        EPI_ROWS(ai, m) { const int r = row0 + ai * 128 + m * 16;
#pragma unroll
            for (int bj = 0; bj < 2; ++bj) { const int c = col0 + 128 * bj; const u32x4 gb = gb_[ai][m][bj];
                const f32x4 g0 = {bf_lo(gb.x), bf_hi(gb.x), bf_lo(gb.y), bf_hi(gb.y)}, g1 = {bf_lo(gb.z), bf_hi(gb.z), bf_lo(gb.w), bf_hi(gb.w)};
                *(u32x4*)(MG + (size_t)r * D + c) = pack8(acc[ai][bj][m][0] * g0, acc[ai][bj][m][1] * g1); } }
    }
};

struct EpiRes {
    static constexpr bool AFTER_DRAIN = true;
    const float* res; float* out; bf16_t* XB; float* xssp; unsigned char* XB8;
    __device__ __forceinline__ void operator()(f32x4 (&)[2][2][4][2], const Unit&, int, int, int, int, LAS unsigned char*) const {}
    __device__ __forceinline__ void fused(f32x4 (&acc)[2][2][4][2], const Unit& u, int wr, int wc, int fr, int fq, LAS unsigned char* lds, int wid, int lane) const {
        LAS float* P = (LAS float*)lds;
        int row0 = u.pm * 256 + wr * 64 + fr; asm volatile("" : "+v"(row0)); const int col0 = u.pn * 256 + 32 * wc + 8 * fq;
#if RES_BF16
        u32x4 xr_[2][4][2];
#pragma unroll
        EPI_ROWS(ai, m) { const int r = row0 + ai * 128 + m * 16;
#pragma unroll
            for (int bj = 0; bj < 2; ++bj) xr_[ai][m][bj] = *(const u32x4*)(XB + (size_t)r * D + col0 + 128 * bj); }
        __builtin_amdgcn_sched_barrier(0);
#pragma unroll
        EPI_ROWS(ai, m) { const int r = row0 + ai * 128 + m * 16; float s = 0.f;
#pragma unroll
            for (int bj = 0; bj < 2; ++bj) { const size_t o = (size_t)r * D + col0 + 128 * bj; const u32x4 xr = xr_[ai][m][bj];
                const f32x4 a = (f32x4){bf_lo(xr.x), bf_hi(xr.x), bf_lo(xr.y), bf_hi(xr.y)} + acc[ai][bj][m][0], b = (f32x4){bf_lo(xr.z), bf_hi(xr.z), bf_lo(xr.w), bf_hi(xr.w)} + acc[ai][bj][m][1];
                *(u32x4*)(XB + o) = pack8(a, b); if (XB8) *(u32x2*)(XB8 + o) = pack8_f8(a, b);
                s += sum4(a * a) + sum4(b * b); }
            s = qsum(s);
            if (fq == 0) P[(ai * 128 + wr * 64 + m * 16 + fr) * 4 + wc] = s; }
#else
#pragma unroll
        EPI_ROWS(ai, m) { const int r = row0 + ai * 128 + m * 16; float s = 0.f;
#pragma unroll
            for (int bj = 0; bj < 2; ++bj) { const size_t o = (size_t)r * D + col0 + 128 * bj;
#if RES_BF16
                const u32x4 xr = *(const u32x4*)(XB + o);
                const f32x4 a = (f32x4){bf_lo(xr.x), bf_hi(xr.x), bf_lo(xr.y), bf_hi(xr.y)} + acc[ai][bj][m][0], b = (f32x4){bf_lo(xr.z), bf_hi(xr.z), bf_lo(xr.w), bf_hi(xr.w)} + acc[ai][bj][m][1];
#else
                const f32x4 a = ld_nt(res + o) + acc[ai][bj][m][0], b = ld_nt(res + o + 4) + acc[ai][bj][m][1];
                *(f32x4*)(out + o) = a; *(f32x4*)(out + o + 4) = b;
#endif
                *(u32x4*)(XB + o) = pack8(a, b); if (XB8) *(u32x2*)(XB8 + o) = pack8_f8(a, b);
                s += sum4(a * a) + sum4(b * b); }
            s = qsum(s);
            if (fq == 0) P[(ai * 128 + wr * 64 + m * 16 + fr) * 4 + wc] = s; }
#endif
        LDS_WAIT(); RAW_BAR();
        const int tid = wid * 64 + lane;
        if (tid < 256) { const f32x4 v = *(const LAS f32x4*)(P + tid * 4); xssp[(size_t)(u.pm * 256 + tid) * 4 + u.pn] = sum4(v); }
    }
};

template <bool MOE> struct EpiGU {
    static constexpr bool AFTER_DRAIN = false;
    const float* xssp; bf16_t* ACT; const float* idxr;
    __device__ __forceinline__ void operator()(f32x4 (&acc)[2][2][4][2], const Unit& u, int wr, int wc, int fr, int fq, LAS unsigned char*) const {
        int row0 = u.pm * 256 + wr * 64 + fr; asm volatile("" : "+v"(row0)); const int col0 = u.pn * 128 + 32 * wc + 8 * fq;
        const int e = u.e, cn = u.cn; int p0 = u.p0 + wr * 64 + fr; asm volatile("" : "+v"(p0));
#if MOE_FP8 && ACT8_WIDE
        if (MOE) {
            float rw_[2][4];
#pragma unroll
            EPI_ROWS(ai, m) { const int pos = p0 + ai * 128 + m * 16; rw_[ai][m] = idxr[e * M + (pos < cn ? pos : cn - 1)]; }
            __builtin_amdgcn_sched_barrier(0);
#pragma unroll
            for (int ai = 0; ai < 2; ++ai)
#pragma unroll
                for (int mp = 0; mp < 2; ++mp) { u32x2 pk[2];
#pragma unroll
                    for (int h = 0; h < 2; ++h) { const int m = 2 * mp + h; const int pos = p0 + ai * 128 + m * 16; const float rs = pos < cn ? rw_[ai][m] : (1.0f / W8_SCALE);
                        f32x4 a = acc[ai][0][m][0] * rs, b = acc[ai][0][m][1] * rs; const f32x4 c = acc[ai][1][m][0] * rs, d = acc[ai][1][m][1] * rs;
                        a = a * sigm4(a) * c; b = b * sigm4(b) * d; pk[h] = pack8_f8(a, b); }
                    const auto s0 = __builtin_amdgcn_permlane16_swap(pk[0].x, pk[1].x, false, false), s1 = __builtin_amdgcn_permlane16_swap(pk[0].y, pk[1].y, false, false);
                    const int r = row0 + ai * 128 + (2 * mp + (fq & 1)) * 16;
                    *(u32x4*)((unsigned char*)ACT + (size_t)r * FF + col0 - 8 * (fq & 1)) = (u32x4){s0[0], s1[0], s0[1], s1[1]}; }
            return; }
#endif
        float rsv[2][4]; { f32x4 xs_[2][4];
#pragma unroll
        EPI_ROWS(ai, m) { const int r = row0 + ai * 128 + m * 16;
            if (MOE) { const int pos = p0 + ai * 128 + m * 16; xs_[ai][m] = (f32x4){idxr[e * M + (pos < cn ? pos : cn - 1)], 0.f, 0.f, 0.f}; }
            else xs_[ai][m] = *(const f32x4*)(xssp + (size_t)r * 4); }
        __builtin_amdgcn_sched_barrier(0);
#pragma unroll
        EPI_ROWS(ai, m) { if (MOE) { const int pos = p0 + ai * 128 + m * 16; rsv[ai][m] = pos < cn ? xs_[ai][m].x : (1.0f / W8_SCALE); } else rsv[ai][m] = frsq(sum4(xs_[ai][m]) * (1.0f / D) + EPS); } }
#pragma unroll
        EPI_ROWS(ai, m) { const int r = row0 + ai * 128 + m * 16; const float rs = rsv[ai][m];
            f32x4 a = acc[ai][0][m][0] * rs, b = acc[ai][0][m][1] * rs; const f32x4 c = acc[ai][1][m][0] * rs, d = acc[ai][1][m][1] * rs;
            a = a * sigm4(a) * c; b = b * sigm4(b) * d;
            if (MOE && MOE_FP8) *(u32x2*)((unsigned char*)ACT + (size_t)r * FF + col0) = pack8_f8(a, b);
            else st_wt(ACT + (size_t)r * FF + col0, pack8(a, b)); }
    }
};

struct EpiMoeDn {
    static constexpr bool AFTER_DRAIN = false;
    bf16_t* Y; const float* idxw;
    __device__ __forceinline__ void operator()(f32x4 (&acc)[2][2][4][2], const Unit& u, int wr, int wc, int fr, int fq, LAS unsigned char*) const {
        const int e = u.e; int p0 = u.p0 + wr * 64 + fr; asm volatile("" : "+v"(p0)); const int cn = u.cn;
        const int col0 = (u.pn & 3) * 256 + 32 * wc + 8 * fq; const int row0 = u.pm * 256 + wr * 64 + fr;
        bf16_t* Yk = Y + (size_t)(u.pn >> 2) * SLOTS * D;
        float wv[2][4];
#pragma unroll
        EPI_ROWS(ai, m) { const int pos = p0 + ai * 128 + m * 16; wv[ai][m] = idxw[e * M + (pos < cn ? pos : cn - 1)]; }
        __builtin_amdgcn_sched_barrier(0);
#pragma unroll
        EPI_ROWS(ai, m) { const int pos = p0 + ai * 128 + m * 16;
            if (pos < cn) { const float w = wv[ai][m] * (1.0f / W8_SCALE); bf16_t* o = Yk + (size_t)(row0 + ai * 128 + m * 16) * D + col0;
#pragma unroll
                for (int bj = 0; bj < 2; ++bj) *(u32x4*)(o + 128 * bj) = pack8(acc[ai][bj][m][0] * w, acc[ai][bj][m][1] * w); } }
    }
};

#define XB_TMO      128
#define XB_XCNT(j)  (256  + 64 * (j))
#define XB_XSUB(j)  (1280 + 64 * (j))
#define XB_XGEN(j)  (2304 + 64 * (j))
#define XB_TOP      3328
#define XB_TOPGEN   3392
#define XCD_BAR_WORDS 3456
#define XB_SPIN_CAP (1u << 18)
__device__ __forceinline__ unsigned xb_ld(unsigned* p)              { return __hip_atomic_load(p, __ATOMIC_RELAXED, __HIP_MEMORY_SCOPE_AGENT); }
__device__ __forceinline__ unsigned xb_add(unsigned* p, unsigned v) { return __hip_atomic_fetch_add(p, v, __ATOMIC_RELAXED, __HIP_MEMORY_SCOPE_AGENT); }
__device__ __forceinline__ unsigned xb_xcc_id() { return (unsigned)__builtin_amdgcn_s_getreg((3 << 11) | 20) & 0xFu; }
#define XB_SPIN(cond, bar) do { unsigned _sp = 0; while (cond) { __builtin_amdgcn_s_sleep(1); \
    if ((++_sp & 255u) == 0u) { if (xb_ld(&(bar)[XB_TMO])) break; if (_sp > XB_SPIN_CAP) { atomicAdd(&(bar)[XB_TMO], 1u); break; } } } } while (0)
struct XcdBarrier { unsigned* bar; unsigned x; volatile LAS unsigned* st; };
__device__ __forceinline__ XcdBarrier xcd_barrier_post(unsigned* bar, volatile LAS unsigned* st) {
    XcdBarrier b; b.bar = bar; b.x = xb_xcc_id(); b.st = st;
    if (threadIdx.x == 0) (void)xb_add(&bar[XB_XCNT(b.x)], 1u);
    return b;
}
__device__ __forceinline__ void xcd_barrier_complete(unsigned* bar, unsigned x, unsigned& nloc, unsigned& nx) {
    const unsigned G = gridDim.x * gridDim.y * gridDim.z;
    unsigned sum, cnt, mine, sp = 0u;
    for (;;) {
        sum = 0u; cnt = 0u; mine = 0u;
#pragma unroll
        for (unsigned j = 0; j < 16; ++j) { const unsigned c = xb_ld(&bar[XB_XCNT(j)]); sum += c; cnt += (c > 0u) ? 1u : 0u; mine = (j == x) ? c : mine; }
        if (sum == G) break;
        __builtin_amdgcn_s_sleep(1);
        if ((++sp & 255u) == 0u) { if (xb_ld(&bar[XB_TMO])) break; if (sp > XB_SPIN_CAP) { atomicAdd(&bar[XB_TMO], 1u); break; } }
    }
    nloc = mine > 0u ? mine : 1u; nx = cnt > 0u ? cnt : 1u;
}
__device__ __forceinline__ void xcd_barrier(const XcdBarrier& b) {
    asm volatile("s_waitcnt vmcnt(0)" ::: "memory");
    __syncthreads();
    if (threadIdx.x == 0) {
        unsigned* bar = b.bar;
        __builtin_amdgcn_s_waitcnt(0);
        unsigned nloc = b.st[0], nx = b.st[1];
        if (nloc == 0u) { xcd_barrier_complete(bar, b.x, nloc, nx); b.st[0] = nloc; b.st[1] = nx; }
        const unsigned old = xb_add(&bar[XB_XSUB(b.x)], 1u);
        const unsigned gen = old / nloc;
        if (old + 1u == (gen + 1u) * nloc) {
            __builtin_amdgcn_fence(__ATOMIC_RELEASE, "agent");
            asm volatile("s_waitcnt vmcnt(0)" ::: "memory");
            const unsigned og = xb_add(&bar[XB_TOP], 1u);
            const unsigned tg = og / nx;
            if (og + 1u == (tg + 1u) * nx) xb_add(&bar[XB_TOPGEN], 1u);
            else XB_SPIN(xb_ld(&bar[XB_TOPGEN]) == tg, bar);
            __builtin_amdgcn_fence(__ATOMIC_ACQUIRE, "agent");
            xb_add(&bar[XB_XGEN(b.x)], 1u);
            asm volatile("s_waitcnt vmcnt(0)" ::: "memory");
        } else {
            XB_SPIN(xb_ld(&bar[XB_XGEN(b.x)]) == gen, bar);
            __builtin_amdgcn_fence(__ATOMIC_ACQUIRE, "agent");
            asm volatile("s_waitcnt vmcnt(0)" ::: "memory");
        }
    }
    __syncthreads();
}

#ifndef ATT_SUM_THR
#define ATT_SUM_THR 1.0e9f
#endif
namespace att {
constexpr int KSLOT = 12288, VSLOT = 8192, SLOT = KSLOT + VSLOT, NSLOT = 4, WSF_OFF = NSLOT * SLOT, OST_OFF = WSF_OFF + 2048, LDS_NEED = OST_OFF + 8 * 4096;
static_assert(LDS_NEED <= RING_BYTES, "attention LDS");
__device__ __forceinline__ void glds16(const void* gsrc, unsigned lds_dst) { unsigned keep;
    asm volatile("s_mov_b32 %0, m0\n\ts_mov_b32 m0, %2\n\ts_nop 0\n\tglobal_load_lds_dwordx4 %1, off\n\ts_mov_b32 m0, %0" : "=&s"(keep) : "v"(gsrc), "s"(lds_dst) : "memory"); }
typedef short v4i16_t __attribute__((ext_vector_type(4)));
typedef LAS const char* lds_cptr;
__device__ __forceinline__ s16x4 vtr(lds_cptr p) { return __builtin_bit_cast(s16x4, __builtin_amdgcn_ds_read_tr16_b64_v4i16((LAS v4i16_t*)p)); }

__device__ __forceinline__ void attn_unit(int b, int h, int qb, const bf16_t* Q, const bf16_t* __restrict__ Kt, const bf16_t* __restrict__ Vt, bf16_t* O, char* shm) {
    int tid = threadIdx.x; asm volatile("" : "+v"(tid));
    const int lane = tid & 63, r32 = lane & 31, hi = lane >> 5; const int wid = __builtin_amdgcn_readfirstlane(tid >> 6);
    const int q0 = qb * 256; const int NT = 4 * (qb + 1);
    const size_t rowbase = (size_t)b * SEQ;
    const bf16_t* Kbh = Kt + (size_t)(b * NH + h) * 32 * 6144;
    const bf16_t* Vbh = Vt + (size_t)(b * NH + h) * 32 * 4096;
    const unsigned lds0 = (unsigned)(uintptr_t)shm;
    const lds_cptr shm3 = (lds_cptr)shm;
    LAS float* wsf = (LAS float*)(shm3 + WSF_OFF) + wid * 64;
#define ATT_DMA(t, sl) do { const bf16_t* kt_ = Kbh + (size_t)(t) * 6144; const bf16_t* vt_ = Vbh + (size_t)(t) * 4096; const unsigned sb_ = lds0 + (sl) * SLOT; \
        glds16(kt_ + wid * 512 + lane * 8, (unsigned)__builtin_amdgcn_readfirstlane(sb_ + wid * 1024)); \
        if (wid < 4) { glds16(kt_ + (wid + 8) * 512 + lane * 8, (unsigned)__builtin_amdgcn_readfirstlane(sb_ + (wid + 8) * 1024)); \
                       glds16(vt_ + (wid + 4) * 512 + lane * 8, (unsigned)__builtin_amdgcn_readfirstlane(sb_ + KSLOT + (wid + 4) * 1024)); } \
        else { glds16(vt_ + (wid - 4) * 512 + lane * 8, (unsigned)__builtin_amdgcn_readfirstlane(sb_ + KSLOT + (wid - 4) * 1024)); } } while (0)
    ATT_DMA(0, 0); ATT_DMA(1, 1);
    bf16x8 qr[6];
    { const bf16_t* Qw = Q + (rowbase + q0 + wid * 32 + r32) * (size_t)(NH * DQK) + h * DQK + hi * 8;
#pragma unroll
      for (int d0 = 0; d0 < 6; ++d0) qr[d0] = *(const bf16x8*)(Qw + d0 * 16); }
    constexpr float SUM_THR = ATT_SUM_THR;
    float mhat = 0.f, l_reg = 0.f; f32x16 o[2]; o[0] = f32x16{}; o[1] = f32x16{}; f32x16 negm = f32x16{};
    const int qrel = wid * 32 + r32;
    const int vpo = ((lane >> 4) & 1) * 32 + (lane & 3) * 8 + (4 * hi + ((lane & 15) >> 2)) * 64;
    asm volatile("s_waitcnt vmcnt(0)" ::: "memory");
    const int grp = wid >> 2;
    u32x4 pw[4]; bool pend = false;
    int sl = 0, slp = 0;
#define ATT_PV(PW, slot) do { const lds_cptr vp_ = shm3 + (slot) * SLOT + KSLOT + vpo; \
        _Pragma("unroll") for (int d0 = 0; d0 < 2; ++d0) _Pragma("unroll") for (int ks = 0; ks < 4; ks += 2) { \
            const s16x4 lo = vtr(vp_ + d0 * 4096 + ks * 1024), hh = vtr(vp_ + d0 * 4096 + ks * 1024 + 512); \
            const s16x4 lo2 = vtr(vp_ + d0 * 4096 + (ks + 1) * 1024), hh2 = vtr(vp_ + d0 * 4096 + (ks + 1) * 1024 + 512); \
            __builtin_amdgcn_sched_barrier(0); \
            const bf16x8 vf = (bf16x8){lo[0], lo[1], lo[2], lo[3], hh[0], hh[1], hh[2], hh[3]}, vf2 = (bf16x8){lo2[0], lo2[1], lo2[2], lo2[3], hh2[0], hh2[1], hh2[2], hh2[3]}; \
            o[d0] = __builtin_amdgcn_mfma_f32_32x32x16_bf16(__builtin_bit_cast(bf16x8, PW[ks]), vf, o[d0], 0, 0, 0); \
            o[d0] = __builtin_amdgcn_mfma_f32_32x32x16_bf16(__builtin_bit_cast(bf16x8, PW[ks + 1]), vf2, o[d0], 0, 0, 0); } } while (0)
    for (int t = 0; t < NT; ++t) {
        if (t > 0) { if (t + 1 < NT) { if (wid < 4) asm volatile("s_waitcnt vmcnt(3)" ::: "memory"); else asm volatile("s_waitcnt vmcnt(2)" ::: "memory"); } else asm volatile("s_waitcnt vmcnt(0)" ::: "memory"); }
        asm volatile("s_waitcnt lgkmcnt(0)\n\ts_barrier" ::: "memory");
        if (t + 2 < NT) { const int s2 = (sl + 2) & 3; ATT_DMA(t + 2, s2); }
        const int slc = sl; sl = (sl + 1) & 3;
        const lds_cptr kp = shm3 + slc * SLOT + hi * 1024 + r32 * 16;
#define ATT_KLD(G_, d0_) const bf16x8 G_##0 = *(const LAS bf16x8*)(kp + (d0_) * 2048), G_##1 = *(const LAS bf16x8*)(kp + (d0_) * 2048 + 512), \
                                      G_##2 = *(const LAS bf16x8*)(kp + ((d0_) + 1) * 2048), G_##3 = *(const LAS bf16x8*)(kp + ((d0_) + 1) * 2048 + 512)
#define ATT_KMM(G_, d0_) do { p0 = __builtin_amdgcn_mfma_f32_32x32x16_bf16(G_##0, qr[d0_], p0, 0, 0, 0); p1 = __builtin_amdgcn_mfma_f32_32x32x16_bf16(G_##1, qr[d0_], p1, 0, 0, 0); \
                              p0 = __builtin_amdgcn_mfma_f32_32x32x16_bf16(G_##2, qr[(d0_) + 1], p0, 0, 0, 0); p1 = __builtin_amdgcn_mfma_f32_32x32x16_bf16(G_##3, qr[(d0_) + 1], p1, 0, 0, 0); } while (0)
        ATT_KLD(ka, 0);
        __builtin_amdgcn_sched_barrier(0);
        if (grp && pend) { ATT_PV(pw, slp); pend = false; }
        slp = slc;
        const int jb = t - (NT - 4);
        if (jb >= 0 && 64 * jb > 32 * wid + 31) continue;
        f32x16 p0 = negm, p1 = negm;
        {
            ATT_KLD(kb, 2);
            __builtin_amdgcn_sched_barrier(0);
            ATT_KMM(ka, 0);
            __builtin_amdgcn_sched_barrier(0);
            ATT_KLD(kc, 4);
            __builtin_amdgcn_sched_barrier(0);
            ATT_KMM(kb, 2);
            __builtin_amdgcn_sched_barrier(0);
            ATT_KMM(kc, 4);
#undef ATT_KLD
#undef ATT_KMM
        }
        if (jb >= 0 && 64 * jb + 63 > 32 * wid) { const int kb = 64 * jb + 4 * hi;
#pragma unroll
            for (int r = 0; r < 16; ++r) { const int kv = kb + (r & 3) + 8 * (r >> 2); if (kv > qrel) p0[r] = -INFINITY; if (kv + 32 > qrel) p1[r] = -INFINITY; } }
        f32x2 sa2 = {0.f, 0.f}, sb2 = {0.f, 0.f};
#pragma unroll
        for (int r = 0; r < 16; r += 2) { p0[r] = fexp2(p0[r]); p0[r + 1] = fexp2(p0[r + 1]); p1[r] = fexp2(p1[r]); p1[r + 1] = fexp2(p1[r + 1]);
            sa2 += (f32x2){p0[r], p0[r + 1]}; sb2 += (f32x2){p1[r], p1[r + 1]}; }
        sa2 += sb2; float sacc = sa2.x + sa2.y;
        if (__any(sacc > SUM_THR)) {
            const float s2 = xmax32(sacc);
            const float dl = s2 > SUM_THR ? floorf(__builtin_amdgcn_logf(s2)) : 0.f; mhat += dl;
            const float f = fexp2(-dl); l_reg *= f; sacc *= f;
#pragma unroll
            for (int r = 0; r < 16; ++r) { p0[r] *= f; p1[r] *= f; negm[r] = -mhat; }
            if (hi == 0) wsf[r32] = f;
            LDS_WAIT();
#pragma unroll
            for (int j = 0; j < 4; ++j) { const f32x4 fv = *(const LAS f32x4*)(wsf + 8 * j + 4 * hi);
#pragma unroll
                for (int i = 0; i < 4; ++i) { o[0][4 * j + i] *= fv[i]; o[1][4 * j + i] *= fv[i]; } }
        }
        l_reg += sacc;
#pragma unroll
        for (int k = 0; k < 2; ++k) {
            pw[k] = (u32x4){cvt_pk_bf16(p0[8 * k], p0[8 * k + 1]), cvt_pk_bf16(p0[8 * k + 2], p0[8 * k + 3]), cvt_pk_bf16(p0[8 * k + 4], p0[8 * k + 5]), cvt_pk_bf16(p0[8 * k + 6], p0[8 * k + 7])};
            pw[2 + k] = (u32x4){cvt_pk_bf16(p1[8 * k], p1[8 * k + 1]), cvt_pk_bf16(p1[8 * k + 2], p1[8 * k + 3]), cvt_pk_bf16(p1[8 * k + 4], p1[8 * k + 5]), cvt_pk_bf16(p1[8 * k + 6], p1[8 * k + 7])};
        }
        if (grp) pend = true; else ATT_PV(pw, slc);
    }
    if (grp && pend) ATT_PV(pw, slp);
#undef ATT_PV
    l_reg = xsum32(l_reg);
    if (hi == 0) wsf[32 + r32] = l_reg;
    LDS_WAIT();
    float rli[16];
#pragma unroll
    for (int j = 0; j < 4; ++j) { const f32x4 f = *(const LAS f32x4*)(wsf + 32 + 8 * j + 4 * hi);
#pragma unroll
        for (int i = 0; i < 4; ++i) rli[4 * j + i] = frcp(f[i]); }
    { LAS bf16_t* stg = (LAS bf16_t*)(shm3 + OST_OFF) + wid * 2048;
#pragma unroll
      for (int r = 0; r < 16; ++r) { const int orow = crow(r, hi);
#pragma unroll
          for (int d0 = 0; d0 < 2; ++d0) stg[orow * 64 + d0 * 32 + r32] = (bf16_t)(cvt_pk_bf16(o[d0][r] * rli[r], 0.f) & 0xffffu); }
      LDS_WAIT();
      bf16_t* Ow = O + (rowbase + q0 + wid * 32) * (size_t)AOO_LD + h * DV;
#pragma unroll
      for (int i = 0; i < 4; ++i) { const int row = i * 8 + (lane >> 3), ch = lane & 7; const u32x4 v = *(const LAS u32x4*)(stg + row * 64 + ch * 8); *(u32x4*)(Ow + (size_t)row * AOO_LD + ch * 8) = v; } }
    asm volatile("s_waitcnt lgkmcnt(0)\n\ts_barrier" ::: "memory");
#undef ATT_DMA
}
}

__device__ __forceinline__ void gmlp_phase(int first, int stride, int nunits, const bf16_t* U, const bf16_t* Vg, const float* vstp, const float* vng, const float* vnb,
                                           const float* wsp, const float* bsp, bf16_t* AO, LAS unsigned char* lds) {
    int tid = threadIdx.x; asm volatile("" : "+v"(tid));
    const int lane = tid & 63, r32 = lane & 31, hi = lane >> 5; const int wid = __builtin_amdgcn_readfirstlane(tid >> 6);
    LAS bf16_t* vnT = (LAS bf16_t*)lds;
    LAS float* st = (LAS float*)(lds + 34816);
    LAS float* MX = (LAS float*)(lds + 36864);
    const int tb = wid >> 1, dh = wid & 1, nk = 2 * (tb + 1);
    const int trow = 32 * tb + r32, dch0 = tid & 15;
#define GM_LOAD(L_, SP, VG, UU) do { const size_t r0_ = (size_t)((L_) >> 7) * SEQ + (size_t)(((L_) >> 3) & 15) * 128; const int g_ = (L_) & 7; \
        if (tid < 128) { const float* p_ = vstp + (r0_ + tid) * 32; _Pragma("unroll") for (int j = 0; j < 8; ++j) SP[j] = *(const f32x4*)(p_ + 4 * j); } \
        _Pragma("unroll") for (int j = 0; j < 4; ++j) { const int q_ = tid + 512 * j, s_ = q_ >> 4; const size_t o_ = (r0_ + s_) * D + 128 * g_ + 8 * dch0; \
            VG[j] = ld_nt(Vg + o_); UU[j] = ld_nt(U + o_); } } while (0)
    int L = first; if (L >= nunits) return;
    f32x4 spA[8]; u32x4 vgA[4], uuA[4];
    GM_LOAD(L, spA, vgA, uuA);
    int gcur = -1; bf16x8 wa[8]; f32x4 bs4[4], g0, g1, b0, b1;
    while (L < nunits) {
        const int Ln = L + stride;
        f32x4 spB[8]; u32x4 vgB[4], uuB[4];
        if (Ln < nunits) GM_LOAD(Ln, spB, vgB, uuB);
        const int g = L & 7; const size_t r0 = (size_t)(L >> 7) * SEQ + (size_t)((L >> 3) & 15) * 128;
        if (g != gcur) { gcur = g;
            const float* wrow = wsp + ((size_t)g * 128 + trow) * 128 + 8 * hi;
#pragma unroll
            for (int kk = 0; kk < 8; ++kk) if (kk < nk) { f32x4 w0 = *(const f32x4*)(wrow + 16 * kk), w1 = *(const f32x4*)(wrow + 16 * kk + 4); const int s0 = 16 * kk + 8 * hi;
#pragma unroll
                for (int e = 0; e < 4; ++e) { if (s0 + e > trow) w0[e] = 0.f; if (s0 + 4 + e > trow) w1[e] = 0.f; }
                wa[kk] = __builtin_bit_cast(bf16x8, pack8(w0, w1)); }
#pragma unroll
            for (int j = 0; j < 4; ++j) bs4[j] = *(const f32x4*)(bsp + g * 128 + 32 * tb + 8 * j + 4 * hi);
            g0 = *(const f32x4*)(vng + 128 * g + 8 * dch0); g1 = *(const f32x4*)(vng + 128 * g + 8 * dch0 + 4);
            b0 = *(const f32x4*)(vnb + 128 * g + 8 * dch0); b1 = *(const f32x4*)(vnb + 128 * g + 8 * dch0 + 4); }
        if (tid < 128) { float s1 = 0.f, s2 = 0.f;
#pragma unroll
            for (int j = 0; j < 8; ++j) { s1 += spA[j].x + spA[j].z; s2 += spA[j].y + spA[j].w; }
            const float mean = s1 * (1.0f / D); const float var = s2 * (1.0f / D) - mean * mean;
            st[tid] = mean; st[128 + tid] = frsq(var + EPS); }
        LDS_WAIT(); RAW_BAR();
#pragma unroll
        for (int j = 0; j < 4; ++j) { const int q = tid + 512 * j, s_ = q >> 4;
            const float mean = st[s_], rstd = st[128 + s_]; const u32x4 w = vgA[j];
            float v[8] = {bf_lo(w.x), bf_hi(w.x), bf_lo(w.y), bf_hi(w.y), bf_lo(w.z), bf_hi(w.z), bf_lo(w.w), bf_hi(w.w)};
#pragma unroll
            for (int e = 0; e < 8; ++e) { const float gg = e < 4 ? g0[e] : g1[e - 4], bb = e < 4 ? b0[e] : b1[e - 4];
                vnT[(8 * dch0 + e) * 136 + (s_ ^ (8 * dch0))] = (bf16_t)(cvt_pk_bf16((v[e] - mean) * rstd * gg + bb, 0.f) & 0xffffu); } }
        LDS_WAIT(); RAW_BAR();
        f32x16 acc[2]; acc[0] = f32x16{}; acc[1] = f32x16{};
#pragma unroll
        for (int kk = 0; kk < 8; kk += 2) if (kk < nk) {
            bf16x8 bfr[2][2];
#pragma unroll
            for (int k2 = 0; k2 < 2; ++k2) { const int s0 = 16 * (kk + k2) + 8 * hi;
#pragma unroll
                for (int db = 0; db < 2; ++db) bfr[k2][db] = *(const LAS bf16x8*)(vnT + (64 * dh + 32 * db + r32) * 136 + (s0 ^ (8 * (8 * dh + 4 * db + (r32 >> 3))))); }
            __builtin_amdgcn_sched_barrier(0);
#pragma unroll
            for (int k2 = 0; k2 < 2; ++k2)
#pragma unroll
                for (int db = 0; db < 2; ++db) acc[db] = __builtin_amdgcn_mfma_f32_32x32x16_bf16(wa[kk + k2], bfr[k2][db], acc[db], 0, 0, 0);
        }
#pragma unroll
        for (int r = 0; r < 16; ++r) { const int t = 32 * tb + crow(r, hi); const float bs = bs4[r >> 2][r & 3];
#pragma unroll
            for (int db = 0; db < 2; ++db) MX[t * 132 + 64 * dh + 32 * db + r32] = acc[db][r] + bs; }
        LDS_WAIT(); RAW_BAR();
#pragma unroll
        for (int j = 0; j < 4; ++j) { const int q = tid + 512 * j, s_ = q >> 4;
            const f32x4 m0 = *(const LAS f32x4*)(MX + s_ * 132 + 8 * dch0), m1 = *(const LAS f32x4*)(MX + s_ * 132 + 8 * dch0 + 4); const u32x4 w = uuA[j];
            const f32x4 ua = {bf_lo(w.x), bf_hi(w.x), bf_lo(w.y), bf_hi(w.y)}, ub = {bf_lo(w.z), bf_hi(w.z), bf_lo(w.w), bf_hi(w.w)};
            *(u32x4*)(AO + (r0 + s_) * AOO_LD + 128 * g + 8 * dch0) = pack8(ua * m0, ub * m1); }
#pragma unroll
        for (int j = 0; j < 8; ++j) spA[j] = spB[j];
#pragma unroll
        for (int j = 0; j < 4; ++j) { vgA[j] = vgB[j]; uuA[j] = uuB[j]; }
        L = Ln;
    }
#undef GM_LOAD
    LDS_WAIT(); RAW_BAR();
}

typedef const __attribute__((address_space(4))) unsigned char* kargp_t;
__device__ __forceinline__ kargp_t kargp() { kargp_t k = (kargp_t)__builtin_amdgcn_kernarg_segment_ptr(); asm volatile("" : "+s"(k)); return k; }
#define KARG(off, T) (*(T const __attribute__((address_space(4)))*)(kargp() + (off)))
#define INP(i) KARG(8 * (i), const float*)
#define OUTP() KARG(184, float*)
#define WSP() KARG(192, unsigned char*)

struct MapNat { __device__ __forceinline__ int operator()(int j4) const { return j4; } };
struct MapW1 { __device__ __forceinline__ int operator()(int j4) const { const int j = 4 * j4;
    if (j < 2816) return j4; if (j >= 3072) return (2848 + (j - 3072)) >> 2; const int p = j - 2816; if (p >= 32) return -1; return (2816 + 16 * ((p >> 2) & 1) + 4 * (p >> 3)) >> 2; } };
struct MapUQ { __device__ __forceinline__ int operator()(int j4) const { const int j = 4 * j4, t = j >> 8, p = j & 255, bj = p >> 7, wc = (p >> 5) & 3, q = p & 31; const int head = 2 * t + (wc >> 1);
    int dim; if (bj == 0) dim = 32 * (wc & 1) + q; else { if (wc & 1) return -1; dim = 64 + 16 * ((q >> 2) & 1) + 4 * (q >> 3); } return (head * DQK + dim) >> 2; } };
struct MapUKV { __device__ __forceinline__ int operator()(int j4) const { const int j = 4 * j4, t = j >> 8, p = j & 255, bj = p >> 7, wc = (p >> 5) & 3, q = p & 31;
    return ((2 * t + (wc >> 1)) * 128 + (wc & 1) * 64 + 32 * bj + q) >> 2; } };
struct MapGU { __device__ __forceinline__ int operator()(int j4) const { const int j = 4 * j4, t = j >> 8, bj = (j >> 7) & 1, q = j & 127; return (bj * FF + 128 * t + q) >> 2; } };

struct TrDesc { const float* W; bf16_t* WT; const float* scale; float mul; int K, Nsrc, mtype, item, ldw, esz; };
__device__ __forceinline__ int tr_map(int mtype, int j4) {
    switch (mtype) { case 1: return MapW1()(j4); case 2: return MapUQ()(j4); case 3: return MapUKV()(j4); case 4: return MapGU()(j4); default: return j4; } }
__device__ __forceinline__ void tr_load(const TrDesc& d, f32x4 (&v)[16], int lane) {
    const int nblk_k = d.K >> 6; const int nb = d.item / nblk_k, kb = d.item - nb * nblk_k; const int k0 = kb * 64, n0 = nb * 64;
    const int g4 = lane & 15, c = lane >> 4;
    const int src4 = tr_map(d.mtype, (n0 >> 2) + g4);
#pragma unroll
    for (int p = 0; p < 2; ++p) { const int kk = k0 + 32 * p + 8 * c;
        f32x4 sc0 = {1.f, 1.f, 1.f, 1.f}, sc1 = sc0; if (d.scale) { sc0 = *(const f32x4*)(d.scale + kk); sc1 = *(const f32x4*)(d.scale + kk + 4); }
#pragma unroll
        for (int i = 0; i < 8; ++i) { const float sc = i < 4 ? sc0[i] : sc1[i - 4];
            if (src4 >= 0) v[8 * p + i] = __builtin_nontemporal_load((const f32x4*)(d.W + (size_t)(kk + i) * d.Nsrc + 4 * src4)) * (sc * d.mul); else v[8 * p + i] = (f32x4){0.f, 0.f, 0.f, 0.f}; } }
}
__device__ __forceinline__ void tr_store(const TrDesc& d, const f32x4 (&v)[16], LAS float*, int lane) {
    const int nblk_k = d.K >> 6; const int nb = d.item / nblk_k, kb = d.item - nb * nblk_k; const int k0 = kb * 64, n0 = nb * 64;
    const int g4 = lane & 15, c = lane >> 4;
    if (d.esz == 1) {
#pragma unroll
        for (int j = 0; j < 4; ++j) {
            const u32x2 c0 = pack8_f8((f32x4){v[0][j], v[1][j], v[2][j], v[3][j]}, (f32x4){v[4][j], v[5][j], v[6][j], v[7][j]});
            const u32x2 c1 = pack8_f8((f32x4){v[8][j], v[9][j], v[10][j], v[11][j]}, (f32x4){v[12][j], v[13][j], v[14][j], v[15][j]});
            const auto t0 = __builtin_amdgcn_permlane32_swap(c0.x, c1.x, false, false), t1 = __builtin_amdgcn_permlane32_swap(c0.y, c1.y, false, false);
            const auto u0 = __builtin_amdgcn_permlane16_swap(t0[0], t0[1], false, false), u1 = __builtin_amdgcn_permlane16_swap(t1[0], t1[1], false, false);
            *(u32x4*)((unsigned char*)d.WT + (size_t)(n0 + 4 * g4 + j) * d.ldw + k0 + 16 * c) = (u32x4){u0[0], u1[0], u0[1], u1[1]}; }
        return; }
#pragma unroll
    for (int p = 0; p < 2; ++p)
#pragma unroll
        for (int j = 0; j < 4; ++j) {
            { u32x4 o;
            o.x = cvt_pk_bf16(v[8 * p + 0][j], v[8 * p + 1][j]); o.y = cvt_pk_bf16(v[8 * p + 2][j], v[8 * p + 3][j]); o.z = cvt_pk_bf16(v[8 * p + 4][j], v[8 * p + 5][j]); o.w = cvt_pk_bf16(v[8 * p + 6][j], v[8 * p + 7][j]);
            *(u32x4*)(d.WT + (size_t)(n0 + 4 * g4 + j) * d.ldw + k0 + 32 * p + 8 * c) = o; } }
}
constexpr int TR_LAYER = 2432, TR_DENSE = 2112, TR_EXP = 2112, TR_TOTAL = 2 * TR_LAYER + TR_DENSE + 8 * TR_EXP;
__device__ __forceinline__ TrDesc tr_decode(int it, unsigned char* ws) {
    TrDesc d; d.scale = nullptr; d.mtype = 0; d.mul = 1.0f; d.esz = 2;
    if (it < 2 * TR_LAYER) { const int l = it / TR_LAYER; int r = it - l * TR_LAYER; unsigned char* wl = ws + WS_WL + l * WL_STRIDE;
        if (r < 1280) { d.ldw = D; d.W = INP(2) + (size_t)l * D * DIN; d.K = D; d.Nsrc = DIN; d.WT = (bf16_t*)(wl + WL_W1T); d.scale = INP(1) + l * D; d.mtype = 1; d.item = r; return d; } r -= 1280;
        if (r < 256) { d.ldw = QL; d.W = INP(9) + (size_t)l * QL * (NH * DQK); d.K = QL; d.Nsrc = NH * DQK; d.WT = (bf16_t*)(wl + WL_WUQ); d.scale = INP(8) + l * QL; d.mtype = 2; d.item = r; return d; } r -= 256;
        if (r < 128) { d.ldw = KVL; d.W = INP(11) + (size_t)l * KVL * (NH * 128); d.K = KVL; d.Nsrc = NH * 128; d.WT = (bf16_t*)(wl + WL_WUKV); d.scale = INP(10) + l * KVL; d.mtype = 3; d.item = r; return d; } r -= 128;
        const int w = r >> 8; d.item = r & 255; d.K = D; d.Nsrc = D;
        d.W = (w == 0 ? INP(7) : w == 1 ? INP(14) : INP(15)) + (size_t)l * D * D; d.ldw = (w == 2) ? D : 2 * D;
        d.WT = (w == 2) ? (bf16_t*)(wl + WL_WOUT) : (bf16_t*)(wl + WL_PA) + w * D; return d; }
    it -= 2 * TR_LAYER;
    if (it < TR_DENSE) {
        if (it < 1408) { d.ldw = D; d.W = INP(17); d.K = D; d.Nsrc = 2 * FF; d.WT = (bf16_t*)(ws + WS_WGU); d.scale = INP(16); d.mtype = 4; d.item = it; return d; }
        d.ldw = FF; d.W = INP(18); d.K = FF; d.Nsrc = D; d.WT = (bf16_t*)(ws + WS_WD); d.item = it - 1408; return d; }
    it -= TR_DENSE;
    const int e = it / TR_EXP; const int r = it - e * TR_EXP;
    if (r < 1408) { d.ldw = D; d.W = INP(21) + (size_t)e * D * 2 * FF; d.K = D; d.Nsrc = 2 * FF; d.WT = (bf16_t*)(ws + WS_MGU + (size_t)e * 2 * FF * D * MESZ); d.scale = INP(16) + D; d.mtype = 4; d.item = r; d.mul = W8_SCALE; d.esz = MESZ; return d; }
    d.ldw = FF; d.W = INP(22) + (size_t)e * FF * D; d.K = FF; d.Nsrc = D; d.WT = (bf16_t*)(ws + WS_MD + (size_t)e * D * FF * MESZ); d.item = r - 1408; d.mul = W8_SCALE; d.esz = MESZ; return d;
}


#ifndef DBG_STOP
#define DBG_STOP (-1)
#endif
__device__ __forceinline__ void dump_bf16(float* out, const bf16_t* src, size_t n, bool first) {
    const size_t gt = (size_t)blockIdx.x * 512 + threadIdx.x, gs = (size_t)gridDim.x * 512;
    for (size_t i = gt; i < (size_t)M * D; i += gs) { float a = first ? 0.f : out[i]; for (size_t j = i; j < n; j += (size_t)M * D) a += bf1(src[j]); out[i] = a; } }
__device__ __forceinline__ void dump_f32(float* out, const float* src, size_t n, bool first) {
    const size_t gt = (size_t)blockIdx.x * 512 + threadIdx.x, gs = (size_t)gridDim.x * 512;
    for (size_t i = gt; i < (size_t)M * D; i += gs) { float a = first ? 0.f : out[i]; for (size_t j = i; j < n; j += (size_t)M * D) a += src[j]; out[i] = a; } }
#define DBG_AT(id, ...) do { if (DBG_STOP == (id)) { GRID_BAR(); unsigned char* ws = WSP(); float* out = OUTP(); (void)ws; __VA_ARGS__; return; } } while (0)
struct Params { const float* in[23]; float* out; unsigned char* ws; int mode, pad; };
static_assert(sizeof(Params) == 208, "kernarg layout");
#ifndef DBG_TWO
#define DBG_TWO 0
#endif
#ifndef REP_MASK
#define REP_MASK 0
#endif
#define REP(id) for (int rep_ = 0; rep_ < (((REP_MASK) >> (id)) & 1) + 1; ++rep_)

__global__ void __launch_bounds__(512, 2) fwd_kernel(Params p) {
    extern __shared__ __attribute__((aligned(16))) unsigned char lds_raw[];
    LAS unsigned char* lds = (LAS unsigned char*)lds_raw;
    { const int tid = threadIdx.x; volatile LAS unsigned* MISC = (volatile LAS unsigned*)(lds + MISC_OFF);
      for (int u = tid; u < 64; u += 512) MISC[u] = 0u;
      __syncthreads();
      (void)xcd_barrier_post((unsigned*)(WSP() + WS_CTL) + CW_BAR, MISC + 8); }
#ifndef BAR_REP
#define BAR_REP 1
#endif
#define GRID_BAR() for (int br_ = 0; br_ < BAR_REP; ++br_) do { XcdBarrier b_; b_.bar = (unsigned*)(WSP() + WS_CTL) + CW_BAR; b_.x = xb_xcc_id(); b_.st = (volatile LAS unsigned*)(lds + MISC_OFF) + 8; xcd_barrier(b_); } while (0)
#define GRID_G ((int)gridDim.x)
#define GRID_BX ((int)blockIdx.x)
#define VCU ((GRID_G % 8 == 0) ? (GRID_BX % 8) * (GRID_G / 8) + GRID_BX / 8 : GRID_BX)

    REP(0) if (!DBG_TWO || KARG(200, int) != 2) {
        unsigned char* ws = WSP();
        int tid = threadIdx.x; asm volatile("" : "+v"(tid)); const int lane = tid & 63, wave = __builtin_amdgcn_readfirstlane(tid >> 6);
        const int G = GRID_G, bx = GRID_BX; const int gw = VCU * 8 + wave, NGW = G * 8;
        LAS float* scr = (LAS float*)(lds + wave * 16640);
        {
            f32x4 va[16], vb[16], vc[16]; int it = gw;
            TrDesc da = tr_decode(TR_TOTAL - 1 - it, ws), db = da, dc = da;
            tr_load(da, va, lane);
            if (it + NGW < TR_TOTAL) { db = tr_decode(TR_TOTAL - 1 - (it + NGW), ws); tr_load(db, vb, lane); }
            while (it < TR_TOTAL) {
                if (it + 2 * NGW < TR_TOTAL) { dc = tr_decode(TR_TOTAL - 1 - (it + 2 * NGW), ws); tr_load(dc, vc, lane); }
                tr_store(da, va, scr, lane); it += NGW; if (it >= TR_TOTAL) break;
                if (it + 2 * NGW < TR_TOTAL) { da = tr_decode(TR_TOTAL - 1 - (it + 2 * NGW), ws); tr_load(da, va, lane); }
                tr_store(db, vb, scr, lane); it += NGW; if (it >= TR_TOTAL) break;
                if (it + 2 * NGW < TR_TOTAL) { db = tr_decode(TR_TOTAL - 1 - (it + 2 * NGW), ws); tr_load(db, vb, lane); }
                tr_store(dc, vc, scr, lane); it += NGW;
            }
        }
        { const float* x = INP(0); bf16_t* XB = (bf16_t*)(ws + WS_XB); float* xssp = (float*)(ws + WS_XSSP);
          for (int m0 = gw; m0 < M; m0 += 4 * NGW) {
            f32x4 v[4][4];
#pragma unroll
            for (int q = 0; q < 4; ++q) { const int m = m0 + q * NGW; if (m < M) { const f32x4* xr = (const f32x4*)(x + (size_t)m * D) + lane;
#pragma unroll
                for (int j = 0; j < 4; ++j) v[q][j] = __builtin_nontemporal_load(xr + 64 * j); } }
            __builtin_amdgcn_sched_barrier(0);
#pragma unroll
            for (int q = 0; q < 4; ++q) { const int m = m0 + q * NGW; if (m < M) { float s = 0.f; u32x2* o8 = (u32x2*)(XB + (size_t)m * D) + lane;
#pragma unroll
                for (int j = 0; j < 4; ++j) { s += sum4(v[q][j] * v[q][j]); o8[64 * j] = (u32x2){cvt_pk_bf16(v[q][j].x, v[q][j].y), cvt_pk_bf16(v[q][j].z, v[q][j].w)}; }
                s = wave_sum(s);
                if (lane == 0) *(f32x4*)(xssp + (size_t)m * 4) = (f32x4){s, 0.f, 0.f, 0.f}; } }
          } }
        for (int i = bx * 512 + tid; i < SEQ * 16; i += G * 512) { const int pos = i >> 4, j = i & 15;
            const float inv = powf(10000.0f, -(float)(2 * j) / 32.0f); const float ang = (float)pos * inv;
            ((float*)(ws + WS_ROPE))[i] = cosf(ang); ((float*)(ws + WS_ROPE))[SEQ * 16 + i] = sinf(ang); }
    }
    if (DBG_TWO && KARG(200, int) == 1) return;
    GRID_BAR();
    DBG_AT(0, dump_bf16(out, (const bf16_t*)(ws + WS_XB), (size_t)M * D, true); dump_f32(out, (const float*)(ws + WS_ROPE), (size_t)SEQ * 32 + (size_t)M * 4, false); dump_bf16(out, (const bf16_t*)(ws + WS_WL), (WS_WD + (size_t)D * FF * 2 - WS_WL) / 2, false); dump_bf16(out, (const bf16_t*)(ws + WS_MGU), (WS_XB - WS_MGU) / 2, false));

#pragma unroll 1
    for (int l = 0; l < 2; ++l) {
        REP(1) {
            unsigned char* ws = WSP(); unsigned char* wl = ws + WS_WL + l * WL_STRIDE;
            const float* cosT = (const float*)(ws + WS_ROPE); const float* sinT = cosT + SEQ * 16;
            SchedStd S; S.init(M / 256, N1 / 256, GRID_G, GRID_BX); S.A = (const char*)(ws + WS_XB); S.Bt = (const char*)(wl + WL_W1T); S.astep = 256 * (size_t)D * 2; S.bstep = 256 * (size_t)D * 2;
            EpiG1 E{(const float*)(ws + WS_XSSP), (bf16_t*)(ws + WS_U), (bf16_t*)(ws + WS_VG), (bf16_t*)(ws + WS_CQ), (bf16_t*)(ws + WS_CKV), (bf16_t*)(ws + WS_G),
                    (float*)(ws + WS_VSTP), (float*)(ws + WS_CQP), (float*)(ws + WS_CKVP), (float*)(ws + WS_KR), (float*)(ws + WS_KRSS), INP(13) + l * DQK, cosT, sinT};
#if DBG_STOP == 21
            EpiRaw ER{(bf16_t*)(ws + WS_U), N1};
            pg8::gemm_phase<EpiRaw, SchedStd, true, false>(lds, D, D, D, S, ER);
#else
            pg8::gemm_phase<EpiG1, SchedStd, true, false>(lds, D, D, D, S, E);
#endif
        }
        GRID_BAR();
        DBG_AT(21, dump_bf16(out, (const bf16_t*)(ws + WS_U), (size_t)M * N1, true));
        if (DBG_STOP == 10 * l + 1) DBG_AT(10 * l + 1, dump_bf16(out, (const bf16_t*)(ws + WS_U), (size_t)M * 4096, true); dump_bf16(out, (const bf16_t*)(ws + WS_CQ), (size_t)M * 768, false); dump_f32(out, (const float*)(ws + WS_VSTP), (size_t)M * 32, false); dump_f32(out, (const float*)(ws + WS_CQP), (size_t)M * 8, false); dump_f32(out, (const float*)(ws + WS_CKVP), (size_t)M * 4, false); dump_f32(out, (const float*)(ws + WS_KRSS), (size_t)M, false); dump_f32(out, (const float*)(ws + WS_KR), (size_t)M * 32, false));
        REP(2) {
            unsigned char* ws = WSP(); unsigned char* wl = ws + WS_WL + l * WL_STRIDE;
            const float* cosT = (const float*)(ws + WS_ROPE); const float* sinT = cosT + SEQ * 16;
            SchedStd S; S.init(M / 256, NQ / 256, GRID_G, GRID_BX); S.A = (const char*)(ws + WS_CQ); S.Bt = (const char*)(wl + WL_WUQ); S.astep = 256 * (size_t)QL * 2; S.bstep = 256 * (size_t)QL * 2;
            EpiQ E{(const float*)(ws + WS_CQP), INP(12) + l * DQK, cosT, sinT, (bf16_t*)(ws + WS_Q)};
            pg8::gemm_phase<EpiQ, SchedStd, true, false>(lds, QL, QL, QL, S, E);
        }
        REP(3) {
            unsigned char* ws = WSP(); unsigned char* wl = ws + WS_WL + l * WL_STRIDE;
            SchedStd S; S.init(M / 256, NKV / 256, GRID_G, GRID_BX); S.A = (const char*)(ws + WS_CKV); S.Bt = (const char*)(wl + WL_WUKV); S.astep = 256 * (size_t)KVL * 2; S.bstep = 256 * (size_t)KVL * 2;
            EpiKV E{(const float*)(ws + WS_CKVP), (const float*)(ws + WS_KRSS), (const float*)(ws + WS_KR), INP(13) + l * DQK, (bf16_t*)(ws + WS_KT), (bf16_t*)(ws + WS_VT)};
            pg8::gemm_phase<EpiKV, SchedStd, true, false>(lds, KVL, KVL, KVL, S, E);
        }
        REP(4) {
            unsigned char* ws = WSP();
            gmlp_phase(VCU, GRID_G, NBATCH * 16 * 8, (const bf16_t*)(ws + WS_U), (const bf16_t*)(ws + WS_VG), (const float*)(ws + WS_VSTP), INP(3) + l * D, INP(4) + l * D,
                       INP(5) + (size_t)l * 8 * 128 * 128, INP(6) + l * 8 * 128, (bf16_t*)(ws + WS_AO), lds);
        }
        GRID_BAR();
        if (DBG_STOP == 10 * l + 2) DBG_AT(10 * l + 2, dump_bf16(out, (const bf16_t*)(ws + WS_Q), (size_t)M * (1536 + 1536 + 1024 + 1024), true));
        if (DBG_STOP == 10 * l + 9) DBG_AT(10 * l + 9, dump_bf16(out, (const bf16_t*)(ws + WS_Q), (size_t)M * 1536, true));
        if (DBG_STOP == 10 * l + 8) DBG_AT(10 * l + 8, dump_bf16(out, (const bf16_t*)(ws + WS_AO), (size_t)M * 1024, true));
        REP(5) {
            unsigned char* ws = WSP();
            for (int L = VCU; L < NBATCH * NH * 4; L += GRID_G) {
                const int bh = L >> 2, pr = L & 3;
                att::attn_unit(bh >> 4, bh & 15, 7 - pr, (const bf16_t*)(ws + WS_Q), (const bf16_t*)(ws + WS_KT), (const bf16_t*)(ws + WS_VT), (bf16_t*)(ws + WS_AO) + 1024, (char*)lds_raw);
                att::attn_unit(bh >> 4, bh & 15, pr, (const bf16_t*)(ws + WS_Q), (const bf16_t*)(ws + WS_KT), (const bf16_t*)(ws + WS_VT), (bf16_t*)(ws + WS_AO) + 1024, (char*)lds_raw);
            }
        }
        GRID_BAR();
        if (DBG_STOP == 10 * l + 3) DBG_AT(10 * l + 3, dump_bf16(out, (const bf16_t*)(ws + WS_O), (size_t)M * D, true));
        REP(6) {
            unsigned char* ws = WSP(); unsigned char* wl = ws + WS_WL + l * WL_STRIDE;
            SchedStd S; S.init(M / 256, D / 256, GRID_G, GRID_BX); S.A = (const char*)(ws + WS_AO); S.Bt = (const char*)(wl + WL_PA); S.astep = 256 * (size_t)AOO_LD * 2; S.bstep = 256 * (size_t)(2 * D) * 2;
            EpiProjF E{(const bf16_t*)(ws + WS_G), (bf16_t*)(ws + WS_MG)};
            pg8::gemm_phase<EpiProjF, SchedStd, true, false>(lds, 2 * D, AOO_LD, 2 * D, S, E);
        }
        GRID_BAR();
        if (DBG_STOP == 10 * l + 4) DBG_AT(10 * l + 4, dump_bf16(out, (const bf16_t*)(ws + WS_MG), (size_t)M * D, true));
        REP(7) {
            unsigned char* ws = WSP(); unsigned char* wl = ws + WS_WL + l * WL_STRIDE;
            SchedStd S; S.init(M / 256, D / 256, GRID_G, GRID_BX); S.A = (const char*)(ws + WS_MG); S.Bt = (const char*)(wl + WL_WOUT); S.astep = 256 * (size_t)D * 2; S.bstep = 256 * (size_t)D * 2;
            EpiRes E{(l == 0) ? INP(0) : (const float*)(ws + WS_X2), (l == 0) ? (float*)(ws + WS_X1) : OUTP(), (bf16_t*)(ws + WS_XB), (float*)(ws + WS_XSSP), (MOE_FP8 && l == 1) ? (unsigned char*)(ws + WS_XB8) : nullptr};
            pg8::gemm_phase<EpiRes, SchedStd, false, false>(lds, D, D, D, S, E);
        }
        GRID_BAR();
        if (DBG_STOP == 5 && l == 0) DBG_AT(5, dump_f32(out, (const float*)(ws + WS_X1), (size_t)M * D, true); dump_f32(out, (const float*)(ws + WS_XSSP), (size_t)M * 4, false); dump_bf16(out, (const bf16_t*)(ws + WS_XB), (size_t)M * D, false));
        if (DBG_STOP == 15 && l == 1) return;
        if (l == 0) {
            REP(8) {
                unsigned char* ws = WSP();
                SchedStd S; S.init(M / 256, 2 * FF / 256, GRID_G, GRID_BX); S.A = (const char*)(ws + WS_XB); S.Bt = (const char*)(ws + WS_WGU); S.astep = 256 * (size_t)D * 2; S.bstep = 256 * (size_t)D * 2;
                EpiGU<false> E{(const float*)(ws + WS_XSSP), (bf16_t*)(ws + WS_ACT), nullptr};
                pg8::gemm_phase<EpiGU<false>, SchedStd, true, false>(lds, D, D, D, S, E);
            }
            GRID_BAR();
            DBG_AT(6, dump_bf16(out, (const bf16_t*)(ws + WS_ACT), (size_t)M * FF, true));
            REP(9) {
                unsigned char* ws = WSP();
                SchedStd S; S.init(M / 256, D / 256, GRID_G, GRID_BX); S.A = (const char*)(ws + WS_ACT); S.Bt = (const char*)(ws + WS_WD); S.astep = 256 * (size_t)FF * 2; S.bstep = 256 * (size_t)FF * 2;
                EpiRes E{(const float*)(ws + WS_X1), (float*)(ws + WS_X2), (bf16_t*)(ws + WS_XB), (float*)(ws + WS_XSSP), nullptr};
                pg8::gemm_phase<EpiRes, SchedStd, false, false>(lds, FF, FF, FF, S, E);
            }
            GRID_BAR();
            DBG_AT(7, dump_f32(out, (const float*)(ws + WS_X2), (size_t)M * D, true); dump_f32(out, (const float*)(ws + WS_XSSP), (size_t)M * 4, false));
        } else {
            {
                unsigned char* ws = WSP(); unsigned* ctl = (unsigned*)(ws + WS_CTL);
                int tid = threadIdx.x; asm volatile("" : "+v"(tid)); const int lane = tid & 63, wave = __builtin_amdgcn_readfirstlane(tid >> 6);
                int* idxt = (int*)(ws + WS_IDXT); float* idxw = (float*)(ws + WS_IDXW); const float* xssp = (const float*)(ws + WS_XSSP);
                LAS int* lcnt = (LAS int*)lds; LAS int* lstart = lcnt + 8; LAS int* lsel = lcnt + 16;
                LAS float* lw = (LAS float*)(lcnt + 16 + 128);
                const float* wr_ = INP(19); const float* br_ = INP(20); const float* gf = INP(16) + D; const float* xo = OUTP();
                f32x4 w0r[16], w1r[16];
#pragma unroll
                for (int j = 0; j < 4; ++j)
#pragma unroll
                    for (int i = 0; i < 4; ++i) { const int k = 4 * lane + 256 * j + i; const float gk_ = gf[k];
                        w0r[4 * j + i] = *(const f32x4*)(wr_ + (size_t)k * 8) * gk_; w1r[4 * j + i] = *(const f32x4*)(wr_ + (size_t)k * 8 + 4) * gk_; }
                for (int chunk = GRID_BX; chunk < M / 64; chunk += GRID_G) {
                    if (tid < 8) lcnt[tid] = 0;
                    __syncthreads();
                    u32x2 xn_[4];
#pragma unroll
                    for (int j = 0; j < 4; ++j) xn_[j] = *(const u32x2*)((const bf16_t*)(ws + WS_XB) + (size_t)(chunk * 64 + wave * 8) * D + 4 * lane + 256 * j);
                    f32x4 xsn_ = *(const f32x4*)(xssp + (size_t)(chunk * 64 + wave * 8) * 4);
#pragma unroll 1
                    for (int q = 0; q < 8; ++q) { const int tl = wave * 8 + q; const int tk = chunk * 64 + tl;
                        u32x2 xc_[4];
#pragma unroll
                        for (int j = 0; j < 4; ++j) xc_[j] = xn_[j];
                        const f32x4 xsc_ = xsn_;
                        { const int tkn = tk + (q < 7 ? 1 : 0);
#pragma unroll
                          for (int j = 0; j < 4; ++j) xn_[j] = *(const u32x2*)((const bf16_t*)(ws + WS_XB) + (size_t)tkn * D + 4 * lane + 256 * j);
                          xsn_ = *(const f32x4*)(xssp + (size_t)tkn * 4); }
                        __builtin_amdgcn_sched_barrier(0);
                        float a[8];
#pragma unroll
                        for (int e = 0; e < 8; ++e) a[e] = 0.f;
#pragma unroll
                        for (int j = 0; j < 4; ++j) { const int k0 = 4 * lane + 256 * j;
#if RES_BF16
                            const u32x2 xw_ = xc_[j]; const f32x4 xv = (f32x4){bf_lo(xw_.x), bf_hi(xw_.x), bf_lo(xw_.y), bf_hi(xw_.y)};
#else
                            const f32x4 xv = *(const f32x4*)(xo + (size_t)tk * D + k0) * *(const f32x4*)(gf + k0);
#endif

#pragma unroll
                            for (int i = 0; i < 4; ++i) { const f32x4 w0 = w0r[4 * j + i], w1 = w1r[4 * j + i];
                                a[0] += xv[i] * w0.x; a[1] += xv[i] * w0.y; a[2] += xv[i] * w0.z; a[3] += xv[i] * w0.w; a[4] += xv[i] * w1.x; a[5] += xv[i] * w1.y; a[6] += xv[i] * w1.z; a[7] += xv[i] * w1.w; } }
#pragma unroll
                        for (int e = 0; e < 8; ++e) a[e] = wave_sum(a[e]);
                        if (lane == 0) { const float rs = 1.0f / sqrtf(sum4(xsc_) * (1.0f / D) + EPS);
                            float lg[8];
#pragma unroll
                            for (int e = 0; e < 8; ++e) lg[e] = a[e] * rs + br_[e];
                            int e0 = 0; float v0 = lg[0];
#pragma unroll
                            for (int e = 1; e < 8; ++e) if (lg[e] > v0) { v0 = lg[e]; e0 = e; }
                            int e1 = -1; float v1 = -INFINITY;
#pragma unroll
                            for (int e = 0; e < 8; ++e) if (e != e0 && lg[e] > v1) { v1 = lg[e]; e1 = e; }
                            const float w1v = 1.0f / (1.0f + expf(v0 - v1)), w0v = 1.0f - w1v;
                            const int i0 = atomicAdd((int*)&lcnt[e0], 1), i1 = atomicAdd((int*)&lcnt[e1], 1);
                            lsel[tl * 2] = e0 | (i0 << 8); lsel[tl * 2 + 1] = e1 | (i1 << 8); lw[tl * 2] = w0v; lw[tl * 2 + 1] = w1v; }
                    }
                    __syncthreads();
                    if (tid < 8) lstart[tid] = (int)atomicAdd(ctl + CW_CNT + 64 * tid, (unsigned)lcnt[tid]);
                    __syncthreads();
                    if (tid < 128) { const int sel = lsel[tid]; const int e = sel & 255, li = sel >> 8; const int pos = lstart[e] + li;
                        const int tk_ = chunk * 64 + (tid >> 1); idxt[e * M + pos] = tk_; idxw[e * M + pos] = lw[tid]; ((int*)(ws + WS_TOKPOS))[chunk * 128 + tid] = e | (pos << 4);
                        ((float*)(ws + WS_IDXR))[e * M + pos] = frsq(sum4(*(const f32x4*)(xssp + (size_t)tk_ * 4)) * (1.0f / D) + EPS) * (1.0f / W8_SCALE); }
                    __syncthreads();
                }
            }
            GRID_BAR();
            REP(10) {
                unsigned char* ws = WSP(); unsigned* ctl = (unsigned*)(ws + WS_CTL);
                moe_table_build(lds, ctl + CW_CNT);
                SchedMoeGu S; S.tt = lds + MOE_TT_OFF; S.init(moe_table_tiles(lds), 2 * FF / 256, GRID_G, GRID_BX); S.XB = (const char*)(ws + (MOE_FP8 ? WS_XB8 : WS_XB)); S.W = (const char*)(ws + WS_MGU); S.idxt = (const int*)(ws + WS_IDXT);
                EpiGU<true> E{(const float*)(ws + WS_XSSP), (bf16_t*)(ws + WS_ACT2), (const float*)(ws + WS_IDXR)};
#if MOE_FP8
                pg8::gemm_phase_f8<EpiGU<true>, SchedMoeGu, true, true>(lds, D, D, D, S, E);
#else
                pg8::gemm_phase<EpiGU<true>, SchedMoeGu, true, true>(lds, D, D, D, S, E);
#endif
            }
            GRID_BAR();
            REP(11) {
                unsigned char* ws = WSP(); unsigned* ctl = (unsigned*)(ws + WS_CTL);
                moe_table_build(lds, ctl + CW_CNT);
                SchedMoeDn S; S.tt = lds + MOE_TT_OFF; S.init(moe_table_tiles(lds), GRID_G, GRID_BX); S.A = (const char*)(ws + WS_ACT2); S.W = (const char*)(ws + WS_MD);
                EpiMoeDn E{(bf16_t*)(ws + WS_Y), (const float*)(ws + WS_IDXW)};
#if MOE_FP8
                pg8::gemm_phase_f8<EpiMoeDn, SchedMoeDn, true, false>(lds, FF / 2, FF, FF, S, E);
#else
                pg8::gemm_phase<EpiMoeDn, SchedMoeDn, true, false>(lds, FF / 2, FF, FF, S, E);
#endif
            }
            GRID_BAR();
            {
                unsigned char* ws = WSP(); const unsigned* cntw = (const unsigned*)(ws + WS_CTL) + CW_CNT;
                int tid = threadIdx.x; asm volatile("" : "+v"(tid)); const int lane = tid & 63, wave = __builtin_amdgcn_readfirstlane(tid >> 6);
                int tsv[8]; { int a_ = 0, c_[8];
#pragma unroll
                    for (int e = 0; e < 8; ++e) c_[e] = (int)__hip_atomic_load(cntw + 64 * e, __ATOMIC_RELAXED, __HIP_MEMORY_SCOPE_AGENT);
                    __builtin_amdgcn_sched_barrier(0);
#pragma unroll
                    for (int e = 0; e < 8; ++e) { tsv[e] = a_ * 256; a_ += (__builtin_amdgcn_readfirstlane(c_[e]) + 255) >> 8; } }
                const int* tokpos = (const int*)(ws + WS_TOKPOS); const bf16_t* Y = (const bf16_t*)(ws + WS_Y); float* out = OUTP();
                for (int tk0 = (VCU * 8 + wave) * 4; tk0 < M; tk0 += GRID_G * 32) {
                    size_t s0[4], s1[4];
                    int tpv[4][2];
#pragma unroll
                    for (int q = 0; q < 4; ++q) { tpv[q][0] = tokpos[2 * (tk0 + q)]; tpv[q][1] = tokpos[2 * (tk0 + q) + 1]; }
                    __builtin_amdgcn_sched_barrier(0);
#pragma unroll
                    for (int q = 0; q < 4; ++q) { const int tp0 = tpv[q][0], tp1 = tpv[q][1]; int b0 = 0, b1 = 0;
#pragma unroll
                        for (int e = 0; e < 8; ++e) { if ((tp0 & 15) == e) b0 = tsv[e]; if ((tp1 & 15) == e) b1 = tsv[e]; }
                        s0[q] = (size_t)(b0 + (tp0 >> 4)) * D; s1[q] = (size_t)(b1 + (tp1 >> 4)) * D; }
#pragma unroll
                    for (int q = 0; q < 4; ++q) {
#pragma unroll
                      for (int j = 0; j < 2; ++j) { const int c = 8 * lane + 512 * j;
                        const u32x4 zz = {0u, 0u, 0u, 0u}; const size_t split0 = (size_t)128 * 256 * D;
                        const u32x4 y0 = ld_nt(Y + s0[q] + c), y1 = (s0[q] >= split0) ? ld_nt(Y + (size_t)SLOTS * D + s0[q] + c) : zz, y2 = ld_nt(Y + s1[q] + c), y3 = (s1[q] >= split0) ? ld_nt(Y + (size_t)SLOTS * D + s1[q] + c) : zz;
                        float* o = out + (size_t)(tk0 + q) * D + c;
#if RES_BF16
                        const u32x4 xr = ld_nt((const bf16_t*)(ws + WS_XB) + (size_t)(tk0 + q) * D + c); f32x4 a = {bf_lo(xr.x), bf_hi(xr.x), bf_lo(xr.y), bf_hi(xr.y)}, b = {bf_lo(xr.z), bf_hi(xr.z), bf_lo(xr.w), bf_hi(xr.w)};
#else
                        f32x4 a = *(const f32x4*)o, b = *(const f32x4*)(o + 4);
#endif
                        a.x += (bf_lo(y0.x) + bf_lo(y1.x)) + (bf_lo(y2.x) + bf_lo(y3.x)); a.y += (bf_hi(y0.x) + bf_hi(y1.x)) + (bf_hi(y2.x) + bf_hi(y3.x));
                        a.z += (bf_lo(y0.y) + bf_lo(y1.y)) + (bf_lo(y2.y) + bf_lo(y3.y)); a.w += (bf_hi(y0.y) + bf_hi(y1.y)) + (bf_hi(y2.y) + bf_hi(y3.y));
                        b.x += (bf_lo(y0.z) + bf_lo(y1.z)) + (bf_lo(y2.z) + bf_lo(y3.z)); b.y += (bf_hi(y0.z) + bf_hi(y1.z)) + (bf_hi(y2.z) + bf_hi(y3.z));
                        b.z += (bf_lo(y0.w) + bf_lo(y1.w)) + (bf_lo(y2.w) + bf_lo(y3.w)); b.w += (bf_hi(y0.w) + bf_hi(y1.w)) + (bf_hi(y2.w) + bf_hi(y3.w));
                        *(f32x4*)o = a; *(f32x4*)(o + 4) = b; } }
                }
            }
        }
    }
}

extern "C" void kernel_launch(void* const* d_in, const int* in_sizes, int n_in, void* d_out, int out_size, void* d_ws, size_t ws_size, hipStream_t stream) {
    static int grid = 0;
    if (grid == 0) {
        if (n_in != 23 || out_size != M * D || ws_size < WS_END) { fprintf(stderr, "kernel_launch: unexpected arguments (n_in %d out %d ws %zu)\n", n_in, out_size, ws_size); grid = -1; return; }
        int dev = 0, cus = 0, per_cu = 0;
        if (hipGetDevice(&dev) != hipSuccess || hipDeviceGetAttribute(&cus, hipDeviceAttributeMultiprocessorCount, dev) != hipSuccess) { grid = -1; return; }
        if (hipFuncSetAttribute((const void*)fwd_kernel, hipFuncAttributeMaxDynamicSharedMemorySize, LDS_BYTES) != hipSuccess) { fprintf(stderr, "kernel_launch: hipFuncSetAttribute failed\n"); grid = -1; return; }
        if (hipOccupancyMaxActiveBlocksPerMultiprocessor(&per_cu, (const void*)fwd_kernel, 512, LDS_BYTES) != hipSuccess || per_cu < 1) { fprintf(stderr, "kernel_launch: occupancy query says %d\n", per_cu); }
        (void)hipGetLastError();
        grid = cus;
    }
    if (grid < 0) return;
    (void)hipMemsetAsync((char*)d_ws + WS_CTL, 0, CTL_ZERO_BYTES, stream);
    Params p{};
    for (int i = 0; i < 23; ++i) p.in[i] = (const float*)d_in[i];
    p.out = (float*)d_out; p.ws = (unsigned char*)d_ws;
#if DBG_TWO
    p.mode = 1; hipLaunchKernelGGL(fwd_kernel, dim3(grid), dim3(512), LDS_BYTES, stream, p);
    (void)hipMemsetAsync((char*)d_ws + WS_CTL, 0, CTL_ZERO_BYTES, stream);
    p.mode = 2; hipLaunchKernelGGL(fwd_kernel, dim3(grid), dim3(512), LDS_BYTES, stream, p);
#else
    hipLaunchKernelGGL(fwd_kernel, dim3(grid), dim3(512), LDS_BYTES, stream, p);
#endif
}
```

```cpp
#include <hip/hip_runtime.h>
#include <cstdio>
#include <cstdint>
#include <type_traits>

#ifndef ACT8_WIDE
#define ACT8_WIDE 1
#endif
#ifndef RES_BF16
#define RES_BF16 1
#endif
#define LAS __attribute__((address_space(3)))
#define GAS __attribute__((address_space(1)))
typedef unsigned short bf16_t;
typedef short bf16x8 __attribute__((ext_vector_type(8)));
typedef short s16x4 __attribute__((ext_vector_type(4)));
typedef float f32x4 __attribute__((ext_vector_type(4)));
typedef float f32x2 __attribute__((ext_vector_type(2)));
typedef float f32x16 __attribute__((ext_vector_type(16)));
typedef unsigned u32x4 __attribute__((ext_vector_type(4)));
typedef unsigned u32x2 __attribute__((ext_vector_type(2)));
typedef GAS unsigned gu32;
typedef int v4i32 __attribute__((ext_vector_type(4)));
typedef int v8i32 __attribute__((ext_vector_type(8)));

constexpr int M = 16384, D = 1024, SEQ = 2048, NBATCH = 8, NH = 16, DQK = 96, DV = 64, QL = 512, KVL = 256, FF = 2816, NE = 8, DIN = 4896;
constexpr int N1 = 5120;
constexpr int NQ = 2048, NKV = 2048;
constexpr int SLOTS = 32768 + 2048;
constexpr float EPS = 1e-6f;
#ifndef MOE_FP8
#define MOE_FP8 1
#endif
constexpr int MESZ = MOE_FP8 ? 1 : 2;
constexpr float W8_SCALE = MOE_FP8 ? 64.0f : 1.0f;
constexpr float C2 = 0.10206207261596577f * 1.4426950408889634f;

constexpr size_t MiB = 1u << 20;
constexpr size_t WS_CTL = 0, CTL_ZERO_BYTES = 1 * MiB;
constexpr size_t WS_ROPE = 1 * MiB;
constexpr size_t WS_XSSP = WS_ROPE + 256 * 1024;
constexpr size_t WS_TOKPOS = WS_ROPE + 512 * 1024;
constexpr size_t WS_VSTP = 2 * MiB;
constexpr size_t WS_CQP = 4 * MiB;
constexpr size_t WS_CKVP = 4 * MiB + 512 * 1024;
constexpr size_t WS_KRSS = 4 * MiB + 768 * 1024;
constexpr size_t WS_KR = 5 * MiB;
constexpr size_t WS_IDXT = 7 * MiB;
constexpr size_t WS_IDXW = 7 * MiB + 512 * 1024;
constexpr size_t WS_WL = 8 * MiB, WL_STRIDE = 19 * MiB;
constexpr size_t WL_W1T = 0, WL_WUQ = 10 * MiB, WL_WUKV = 12 * MiB, WL_PA = 13 * MiB, WL_PB = 15 * MiB, WL_WOUT = 17 * MiB;
constexpr size_t WS_WGU = 46 * MiB;
constexpr size_t WS_WD = 57 * MiB;
constexpr size_t WS_MGU = 63 * MiB;
constexpr size_t WS_MD = 151 * MiB;
constexpr size_t WS_XB = 195 * MiB;
constexpr size_t WS_X2 = 227 * MiB;
constexpr size_t WS_U = 291 * MiB, WS_VG = 323 * MiB, WS_G = 355 * MiB, WS_Q = 419 * MiB, WS_KT = 467 * MiB, WS_VT = 515 * MiB;
constexpr size_t WS_AO = 547 * MiB, WS_O = 579 * MiB, WS_CQ = 611 * MiB, WS_CKV = 627 * MiB, WS_IDXR = 635 * MiB  , WS_END = 636 * MiB;
constexpr int AOO_LD = 2048;
constexpr size_t WS_T = WS_U;
constexpr size_t WS_MG = WS_Q;
constexpr size_t WS_X1 = WS_G;
constexpr size_t WS_ACT = WS_Q;
constexpr size_t WS_ACT2 = WS_U;
static_assert(WS_ACT + (size_t)M * FF * 2 <= WS_AO, "ACT overlay");
static_assert(WS_ACT2 + (size_t)SLOTS * FF * 2 <= WS_VT, "ACT2 overlay");
constexpr size_t WS_XB8 = 616 * MiB;
constexpr size_t WS_Y = 480 * MiB;
static_assert(WS_ACT2 + (size_t)SLOTS * FF * 2 <= WS_Y && WS_Y + (size_t)2 * SLOTS * D * 2 <= WS_END, "Y overlay");
constexpr int CW_BAR = 4096, CW_CNT = 16384  , CW_DBG = 32768;

constexpr int RING_BYTES = 131072;
constexpr int XCH_OFF = RING_BYTES;
constexpr int MISC_OFF = RING_BYTES + 4096;
constexpr int LDS_BYTES = 147456;

typedef __bf16 bf16x2_t __attribute__((ext_vector_type(2)));
__device__ __forceinline__ unsigned cvt_pk_bf16(float lo, float hi) { f32x2 v = {lo, hi}; bf16x2_t b = __builtin_convertvector(v, bf16x2_t); return __builtin_bit_cast(unsigned, b); }
__device__ __forceinline__ float bf_lo(unsigned u) { return __uint_as_float(u << 16); }
__device__ __forceinline__ float bf_hi(unsigned u) { return __uint_as_float(u & 0xffff0000u); }
__device__ __forceinline__ float bf1(bf16_t b) { return __uint_as_float(((unsigned)b) << 16); }
__device__ __forceinline__ float fexp2(float x) { return __builtin_amdgcn_exp2f(x); }
__device__ __forceinline__ float frcp(float x) { return __builtin_amdgcn_rcpf(x); }
__device__ __forceinline__ float frsq(float x) { return __builtin_amdgcn_rsqf(x); }
__device__ __forceinline__ float gelu_t(float v) { return v * frcp(1.0f + fexp2(-2.3022082f * v * (1.0f + 0.044715f * v * v))); }
__device__ __forceinline__ float sigm(float v) { return frcp(1.0f + fexp2(-1.4426950409f * v)); }
__device__ __forceinline__ f32x2 sigm2(f32x2 v) { const f32x2 t = v * (-1.4426950409f); f32x2 e; e.x = fexp2(t.x); e.y = fexp2(t.y); const f32x2 d = e + 1.0f; f32x2 r; r.x = frcp(d.x); r.y = frcp(d.y); return r; }
__device__ __forceinline__ f32x2 gelu2(f32x2 v) { const f32x2 u = v * (v * v * 0.044715f + 1.0f); return v * sigm2(u * 1.5957691216f); }
__device__ __forceinline__ f32x4 gelu4(f32x4 a) { const f32x2 lo = gelu2((f32x2){a.x, a.y}), hi = gelu2((f32x2){a.z, a.w}); return (f32x4){lo.x, lo.y, hi.x, hi.y}; }
__device__ __forceinline__ f32x4 sigm4(f32x4 a) { const f32x2 lo = sigm2((f32x2){a.x, a.y}), hi = sigm2((f32x2){a.z, a.w}); return (f32x4){lo.x, lo.y, hi.x, hi.y}; }
__device__ __forceinline__ int crow(int r, int hi) { return (r & 3) + 8 * (r >> 2) + 4 * hi; }
#define LDS_WAIT() asm volatile("s_waitcnt lgkmcnt(0)" ::: "memory")
#define VM_WAIT() asm volatile("s_waitcnt vmcnt(0)" ::: "memory")
#define RAW_BAR() do { asm volatile("" ::: "memory"); __builtin_amdgcn_s_barrier(); asm volatile("" ::: "memory"); } while (0)

namespace pg8 {
constexpr int BM = 256, BK = 64, HALF = 128, HTB = HALF * BK * 2, STAGE_BYTES = 8 * HTB, NXCD = 8, WGM = 8;
__host__ __device__ __forceinline__ int lds_byte(int r, int c) { const int st = (r >> 4) * 2 + (c >> 5), rr = r & 15, cc = c & 31, ob = rr * 64 + cc * 2; return st * 1024 + (ob ^ (((ob >> 9) & 1) << 5)); }
__host__ __device__ __forceinline__ void stage_rc(int b, int& R, int& C) { const int st = b / 1024, sb = b % 1024, swz = sb ^ (((sb >> 9) & 1) << 5); R = (st >> 1) * 16 + swz / 64; C = (st & 1) * 32 + (swz % 64) / 2; }
__host__ __device__ __forceinline__ int perm32(int rho) { const int n = rho >> 4, i = rho & 15; return 8 * (i >> 2) + 4 * n + (i & 3); }
struct Unit { int pm, pn, e, p0, cn, nt; };
struct StaticOrder {
    int nM, nN, nwg, G, c;
    __device__ __forceinline__ void init(int nM_, int nN_, int G_, int c_) { nM = nM_; nN = nN_; nwg = nM * nN; G = G_; c = c_; }
    __device__ __forceinline__ bool next(int i, Unit& u) const {
        const long L = (long)i * G + c; if (L >= nwg) return false;
        int wgid = (int)L; { const int q = nwg / NXCD, r = nwg % NXCD, xcd = wgid % NXCD, off = wgid / NXCD; wgid = (xcd < r ? xcd * (q + 1) : r * (q + 1) + (xcd - r) * q) + off; }
        const int nig = WGM * nN, gid = wgid / nig, fm = gid * WGM, gsz = (nM - fm) < WGM ? (nM - fm) : WGM;
        u.pm = fm + ((wgid % nig) % gsz); u.pn = (wgid % nig) / gsz; u.e = 0; u.p0 = 0; u.cn = 0; u.nt = 0; return true;
    }
};
template <class T, class = void> struct HasMid : std::false_type {};
template <class T> struct HasMid<T, std::void_t<decltype(&T::mid)>> : std::true_type {};
constexpr int UT_OFF = MISC_OFF + 4096, UT_N = 32;
typedef int i32x4u __attribute__((ext_vector_type(4)));
template <class Sched> __device__ __forceinline__ void unit_table_build(LAS unsigned char* lds, const Sched& S) {
    int tid = threadIdx.x; asm volatile("" : "+v"(tid));
    if (tid < UT_N) { int z = 0; asm volatile("" : "+v"(z));
        Unit u; u.pm = z - 1; u.pn = z; u.e = z; u.p0 = z; u.cn = z; u.nt = z; const bool ok = S.next(tid, u); if (!ok) u.pm = z - 1;
        *(LAS i32x4u*)(lds + UT_OFF + 32 * tid) = (i32x4u){u.pm, u.pn, u.e, u.p0}; *(LAS int*)(lds + UT_OFF + 32 * tid + 16) = u.cn; *(LAS int*)(lds + UT_OFF + 32 * tid + 20) = u.nt; }
    asm volatile("s_waitcnt lgkmcnt(0)" ::: "memory"); __builtin_amdgcn_s_barrier(); asm volatile("" ::: "memory");
}
__device__ __forceinline__ bool unit_get(LAS unsigned char* lds, int i, Unit& u) {
    if (i >= UT_N) return false;
    int o_ = UT_OFF + 32 * i; asm volatile("" : "+s"(o_));
    const i32x4u a = *(const LAS i32x4u*)(lds + o_); const int b0 = *(const LAS int*)(lds + o_ + 16), b1 = *(const LAS int*)(lds + o_ + 20);
    u.pm = __builtin_amdgcn_readfirstlane(a.x); u.pn = __builtin_amdgcn_readfirstlane(a.y); u.e = __builtin_amdgcn_readfirstlane(a.z); u.p0 = __builtin_amdgcn_readfirstlane(a.w);
    u.cn = __builtin_amdgcn_readfirstlane(b0); u.nt = __builtin_amdgcn_readfirstlane(b1); return u.pm >= 0;
}
template <class Epi, class Sched, bool ALIGN_EPI, bool GATHER>
__device__ __forceinline__ void gemm_phase(LAS unsigned char* lds, const int K, const int lda, const int ldb, const Sched& S, const Epi& E) {
    int tid = threadIdx.x; asm volatile("" : "+v"(tid));
    const int wid = __builtin_amdgcn_readfirstlane(tid >> 6), lane = tid & 63, wr = wid >> 2, wc = wid & 3, fr = lane & 15, fq = lane >> 4;
    int nt = K / BK; asm volatile("" : "+s"(nt));
    int Rr[2], Cc[2]; unsigned voffB[2];
#pragma unroll
    for (int i = 0; i < 2; ++i) { stage_rc(tid * 16 + i * 8192, Rr[i], Cc[i]); const int Rb = (Rr[i] & ~31) + perm32(Rr[i] & 31); voffB[i] = (unsigned)(Rb * ldb + Cc[i]) * 2u; }
    const size_t kstep = (size_t)(BK * 2);
    const size_t hstepB = (size_t)HALF * ldb * 2;
    const unsigned ldsw = (unsigned)wid * 1024u;
    const int aoff = lds_byte(wr * 64 + fr, fq * 8), boff = lds_byte(wc * 32 + fr, fq * 8);
#define PG8_SA(b, h) (((b) * 2 + (h)) * HTB)
#define PG8_SB(b, h) ((4 + (b) * 2 + (h)) * HTB)
#define PG8_STAGE(bufoff, gbase, voff) do { _Pragma("unroll") for (int _i = 0; _i < 2; ++_i) \
        __builtin_amdgcn_global_load_lds((const unsigned*)((const char*)(gbase) + (voff)[_i]), (LAS unsigned*)(lds + (bufoff) + ldsw + _i * 8192), 16, 0, 0); } while (0)
#define PG8_LDA(dst, b, h) do { _Pragma("unroll") for (int m = 0; m < 4; ++m) _Pragma("unroll") for (int k = 0; k < 2; ++k) dst[m][k] = *(const LAS bf16x8*)(lds + PG8_SA(b, h) + aoff + m * 2048 + k * 1024); } while (0)
#define PG8_LDB(dst, b, h) do { _Pragma("unroll") for (int n = 0; n < 2; ++n) _Pragma("unroll") for (int k = 0; k < 2; ++k) dst[n][k] = *(const LAS bf16x8*)(lds + PG8_SB(b, h) + boff + n * 2048 + k * 1024); } while (0)
#define PG8_MMA(ai, bj, At, Bt) do { __builtin_amdgcn_s_setprio(1); _Pragma("unroll") for (int m = 0; m < 4; ++m) _Pragma("unroll") for (int n = 0; n < 2; ++n) _Pragma("unroll") for (int k = 0; k < 2; ++k) \
        acc[ai][bj][m][n] = __builtin_amdgcn_mfma_f32_16x16x32_bf16(Bt[n][k], At[m][k], acc[ai][bj][m][n], 0, 0, 0); __builtin_amdgcn_s_setprio(0); } while (0)
#define PG8_WAIT_V(n) asm volatile("s_waitcnt vmcnt(" #n ")" ::: "memory")
#define PG8_WAIT_L(n) asm volatile("s_waitcnt lgkmcnt(" #n ")" ::: "memory")
#define PG8_BAR __builtin_amdgcn_s_barrier()
#define PG8_SCHED __builtin_amdgcn_sched_barrier(0)
#define PG8_SETVO(V, U_) do { _Pragma("unroll") for (int _h = 0; _h < 2; ++_h) _Pragma("unroll") for (int _i = 0; _i < 2; ++_i) { \
        const int _rl = _h * HALF + Rr[_i]; const int _row = GATHER ? S.tok(U_, _rl) : _rl; V[_h][_i] = (unsigned)(_row * lda + Cc[_i]) * 2u; } } while (0)
    Unit cur, nxt; int ui = 0;
    unit_table_build(lds, S);
    if (!unit_get(lds, 0, cur)) return;
    if (cur.nt > 0) { nt = cur.nt; asm volatile("" : "+s"(nt)); }
    f32x4 acc[2][2][4][2];
#pragma unroll
    for (int a = 0; a < 2; ++a)
#pragma unroll
        for (int b = 0; b < 2; ++b)
#pragma unroll
            for (int m = 0; m < 4; ++m)
#pragma unroll
                for (int n = 0; n < 2; ++n) acc[a][b][m][n] = (f32x4){0.f, 0.f, 0.f, 0.f};
    bf16x8 At[4][2], B0[2][2], B1[2][2];
    unsigned vo[2][2], nvo[2][2];
    PG8_SETVO(vo, cur);
#pragma unroll
    for (int h = 0; h < 2; ++h)
#pragma unroll
        for (int i = 0; i < 2; ++i) nvo[h][i] = vo[h][i];
    const char* cA = S.abase(cur); const char* cB = S.bbase(cur);
    PG8_STAGE(PG8_SB(0, 0), cB, voffB); PG8_STAGE(PG8_SB(0, 1), cB + hstepB, voffB); PG8_STAGE(PG8_SA(0, 0), cA, vo[0]); PG8_STAGE(PG8_SA(0, 1), cA, vo[1]);
    PG8_STAGE(PG8_SB(1, 0), cB + kstep, voffB); PG8_STAGE(PG8_SA(1, 0), cA + kstep, vo[0]); PG8_STAGE(PG8_SB(1, 1), cB + hstepB + kstep, voffB);
    if (wr == 1) PG8_BAR;
    PG8_WAIT_V(8); PG8_BAR;
    PG8_WAIT_V(6); PG8_BAR;
    for (;;) {
        const bool has_next = unit_get(lds, ui + 1, nxt);
        const char* nA = has_next ? S.abase(nxt) : cA; const char* nB = has_next ? S.bbase(nxt) : cB;
        if (GATHER) { if (has_next) PG8_SETVO(nvo, nxt); }
        for (int t = 0; t < nt; t += 2) {
            if constexpr (HasMid<Epi>::value) { if (t == (nt >> 1)) { asm volatile("" ::: "memory"); E.mid(acc, cur, wr, wc, fr, fq); asm volatile("" ::: "memory"); } }
            const bool last = (t == nt - 2);
            const char* a1 = cA + (size_t)(t + 1) * kstep;
            const char* a2 = last ? nA : cA + (size_t)(t + 2) * kstep; const char* b2 = last ? nB : cB + (size_t)(t + 2) * kstep;
            const char* a3 = a2 + kstep; const char* b3 = b2 + kstep;
            unsigned v2[2][2];
#pragma unroll
            for (int h = 0; h < 2; ++h)
#pragma unroll
                for (int i = 0; i < 2; ++i) v2[h][i] = GATHER ? (last ? nvo[h][i] : vo[h][i]) : vo[h][i];
            PG8_LDB(B0, 0, 0); PG8_LDB(B1, 0, 1); PG8_SCHED; PG8_LDA(At, 0, 0); PG8_STAGE(PG8_SA(1, 1), a1, vo[1]);
            PG8_WAIT_V(8); PG8_WAIT_L(0); PG8_BAR; PG8_MMA(0, 0, At, B0); PG8_MMA(0, 1, At, B1); PG8_BAR; PG8_SCHED;
            PG8_LDA(At, 0, 1); PG8_STAGE(PG8_SB(0, 0), b2, voffB); PG8_STAGE(PG8_SB(0, 1), b2 + hstepB, voffB); PG8_STAGE(PG8_SA(0, 0), a2, v2[0]);
            PG8_WAIT_V(8); PG8_WAIT_L(0); PG8_BAR; PG8_MMA(1, 0, At, B0); PG8_MMA(1, 1, At, B1); PG8_BAR; PG8_SCHED;
            PG8_LDB(B0, 1, 0); PG8_LDB(B1, 1, 1); PG8_SCHED; PG8_LDA(At, 1, 0); PG8_STAGE(PG8_SA(0, 1), a2, v2[1]);
            PG8_WAIT_V(8); PG8_WAIT_L(0); PG8_BAR; PG8_MMA(0, 0, At, B0); PG8_MMA(0, 1, At, B1); PG8_BAR; PG8_SCHED;
            PG8_LDA(At, 1, 1); PG8_STAGE(PG8_SB(1, 0), b3, voffB); PG8_STAGE(PG8_SB(1, 1), b3 + hstepB, voffB); PG8_STAGE(PG8_SA(1, 0), a3, v2[0]);
            PG8_WAIT_V(8); PG8_WAIT_L(0); PG8_BAR; PG8_MMA(1, 0, At, B0); PG8_MMA(1, 1, At, B1); PG8_BAR; PG8_SCHED;
        }
        if constexpr (ALIGN_EPI) { if (wr == 0) PG8_BAR; }
        asm volatile("" ::: "memory");
        if constexpr (!Epi::AFTER_DRAIN) { E(acc, cur, wr, wc, fr, fq, lds); }
        asm volatile("" ::: "memory");
        if (!has_next) break;
#pragma unroll
        for (int a = 0; a < 2; ++a)
#pragma unroll
            for (int b = 0; b < 2; ++b)
#pragma unroll
                for (int m = 0; m < 4; ++m)
#pragma unroll
                    for (int n = 0; n < 2; ++n) acc[a][b][m][n] = (f32x4){0.f, 0.f, 0.f, 0.f};
        cur = nxt; cA = nA; cB = nB; ++ui; if (cur.nt > 0) { nt = cur.nt; asm volatile("" : "+s"(nt)); }
        if (GATHER) {
#pragma unroll
            for (int h = 0; h < 2; ++h)
#pragma unroll
                for (int i = 0; i < 2; ++i) vo[h][i] = nvo[h][i];
        }
        if constexpr (ALIGN_EPI) { if (wr == 1) PG8_BAR; }
    }
    PG8_WAIT_V(0);
    if constexpr (!ALIGN_EPI) { if (wr == 0) PG8_BAR; }
    PG8_BAR;
    asm volatile("" ::: "memory");
    if constexpr (Epi::AFTER_DRAIN) { E.fused(acc, cur, wr, wc, fr, fq, lds, wid, lane); }
    asm volatile("" ::: "memory");
#undef PG8_SA
#undef PG8_SB
#undef PG8_STAGE
#undef PG8_LDA
#undef PG8_LDB
#undef PG8_MMA
#undef PG8_WAIT_V
#undef PG8_WAIT_L
#undef PG8_BAR
#undef PG8_SCHED
#undef PG8_SETVO
}
template <class Epi, class Sched, bool ALIGN_EPI, bool GATHER>
__device__ __forceinline__ void gemm_phase_f8(LAS unsigned char* lds, const int K, const int lda, const int ldb, const Sched& S, const Epi& E) {
    int tid = threadIdx.x; asm volatile("" : "+v"(tid));
    const int wid = __builtin_amdgcn_readfirstlane(tid >> 6), lane = tid & 63, wr = wid >> 2, wc = wid & 3, fr = lane & 15, fq = lane >> 4;
    int nt = K / (2 * BK); asm volatile("" : "+s"(nt));
    int Rr[2], Cc[2]; unsigned voffB[2];
#pragma unroll
    for (int i = 0; i < 2; ++i) { stage_rc(tid * 16 + i * 8192, Rr[i], Cc[i]); const int Rb = (Rr[i] & ~31) + perm32(Rr[i] & 31); voffB[i] = (unsigned)(Rb * ldb + Cc[i] * 2); }
    const size_t kstep = (size_t)(BK * 2);
    const size_t hstepB = (size_t)HALF * ldb;
    const unsigned ldsw = (unsigned)wid * 1024u;
    const int aoff = lds_byte(wr * 64 + fr, fq * 8), boff = lds_byte(wc * 32 + fr, fq * 8);
#define PG8_SA(b, h) (((b) * 2 + (h)) * HTB)
#define PG8_SB(b, h) ((4 + (b) * 2 + (h)) * HTB)
#define PG8_STAGE(bufoff, gbase, voff) do { _Pragma("unroll") for (int _i = 0; _i < 2; ++_i) \
        __builtin_amdgcn_global_load_lds((const unsigned*)((const char*)(gbase) + (voff)[_i]), (LAS unsigned*)(lds + (bufoff) + ldsw + _i * 8192), 16, 0, 0); } while (0)
#define PG8_LD16(off) (*(const LAS bf16x8*)(lds + (off)))
#define PG8_CAT8(lo, hi) __builtin_shufflevector(__builtin_bit_cast(v4i32, lo), __builtin_bit_cast(v4i32, hi), 0, 1, 2, 3, 4, 5, 6, 7)
#define PG8_LDA(dst, b, h) do { _Pragma("unroll") for (int m = 0; m < 4; ++m) dst[m] = PG8_CAT8(PG8_LD16(PG8_SA(b, h) + aoff + m * 2048), PG8_LD16(PG8_SA(b, h) + aoff + m * 2048 + 1024)); } while (0)
#define PG8_LDB(dst, b, h) do { _Pragma("unroll") for (int n = 0; n < 2; ++n) dst[n] = PG8_CAT8(PG8_LD16(PG8_SB(b, h) + boff + n * 2048), PG8_LD16(PG8_SB(b, h) + boff + n * 2048 + 1024)); } while (0)
#define PG8_MMA(ai, bj, At, Bt) do { __builtin_amdgcn_s_setprio(1); asm volatile("s_nop 1"); _Pragma("unroll") for (int m = 0; m < 4; ++m) _Pragma("unroll") for (int n = 0; n < 2; ++n) \
        asm volatile("v_mfma_f32_16x16x128_f8f6f4 %0, %1, %2, %0" : "+v"(acc[ai][bj][m][n]) : "v"(Bt[n]), "v"(At[m])); __builtin_amdgcn_s_setprio(0); } while (0)
#define PG8_WAIT_V(n) asm volatile("s_waitcnt vmcnt(" #n ")" ::: "memory")
#define PG8_WAIT_L(n) asm volatile("s_waitcnt lgkmcnt(" #n ")" ::: "memory")
#define PG8_BAR __builtin_amdgcn_s_barrier()
#define PG8_SCHED __builtin_amdgcn_sched_barrier(0)
#define PG8_SETVO(V, U_) do { int _row4[4]; if constexpr (GATHER) S.tok4(U_, Rr[0], Rr[1], _row4); \
        _Pragma("unroll") for (int _h = 0; _h < 2; ++_h) _Pragma("unroll") for (int _i = 0; _i < 2; ++_i) { \
        const int _rl = _h * HALF + Rr[_i]; const int _row = GATHER ? _row4[2 * _h + _i] : _rl; V[_h][_i] = (unsigned)(_row * lda + Cc[_i] * 2); } } while (0)
    Unit cur, nxt; int ui = 0;
    unit_table_build(lds, S);
    if (!unit_get(lds, 0, cur)) return;
    if (cur.nt > 0) { nt = cur.nt; asm volatile("" : "+s"(nt)); }
    f32x4 acc[2][2][4][2];
#pragma unroll
    for (int a = 0; a < 2; ++a)
#pragma unroll
        for (int b = 0; b < 2; ++b)
#pragma unroll
            for (int m = 0; m < 4; ++m)
#pragma unroll
                for (int n = 0; n < 2; ++n) acc[a][b][m][n] = (f32x4){0.f, 0.f, 0.f, 0.f};
    v8i32 At[4], B0[2], B1[2];
    unsigned vo[2][2], nvo[2][2];
    PG8_SETVO(vo, cur);
#pragma unroll
    for (int h = 0; h < 2; ++h)
#pragma unroll
        for (int i = 0; i < 2; ++i) nvo[h][i] = vo[h][i];
    const char* cA = S.abase(cur); const char* cB = S.bbase(cur);
    PG8_STAGE(PG8_SB(0, 0), cB, voffB); PG8_STAGE(PG8_SB(0, 1), cB + hstepB, voffB); PG8_STAGE(PG8_SA(0, 0), cA, vo[0]); PG8_STAGE(PG8_SA(0, 1), cA, vo[1]);
    PG8_STAGE(PG8_SB(1, 0), cB + kstep, voffB); PG8_STAGE(PG8_SA(1, 0), cA + kstep, vo[0]); PG8_STAGE(PG8_SB(1, 1), cB + hstepB + kstep, voffB);
    if (wr == 1) PG8_BAR;
    PG8_WAIT_V(8); PG8_BAR;
    PG8_WAIT_V(6); PG8_BAR;
    for (;;) {
        const bool has_next = unit_get(lds, ui + 1, nxt);
        const char* nA = has_next ? S.abase(nxt) : cA; const char* nB = has_next ? S.bbase(nxt) : cB;
        if (GATHER) { if (has_next) PG8_SETVO(nvo, nxt); }
        for (int t = 0; t < nt; t += 2) {
            if constexpr (HasMid<Epi>::value) { if (t == (nt >> 1)) { asm volatile("" ::: "memory"); E.mid(acc, cur, wr, wc, fr, fq); asm volatile("" ::: "memory"); } }
            const bool last = (t == nt - 2);
            const char* a1 = cA + (size_t)(t + 1) * kstep;
            const char* a2 = last ? nA : cA + (size_t)(t + 2) * kstep; const char* b2 = last ? nB : cB + (size_t)(t + 2) * kstep;
            const char* a3 = a2 + kstep; const char* b3 = b2 + kstep;
            unsigned v2[2][2];
#pragma unroll
            for (int h = 0; h < 2; ++h)
#pragma unroll
                for (int i = 0; i < 2; ++i) v2[h][i] = GATHER ? (last ? nvo[h][i] : vo[h][i]) : vo[h][i];
            PG8_LDB(B0, 0, 0); PG8_LDB(B1, 0, 1); PG8_SCHED; PG8_LDA(At, 0, 0); PG8_STAGE(PG8_SA(1, 1), a1, vo[1]);
            PG8_WAIT_V(8); PG8_WAIT_L(0); PG8_BAR; PG8_MMA(0, 0, At, B0); PG8_MMA(0, 1, At, B1); PG8_BAR; PG8_SCHED;
            PG8_LDA(At, 0, 1); PG8_STAGE(PG8_SB(0, 0), b2, voffB); PG8_STAGE(PG8_SB(0, 1), b2 + hstepB, voffB); PG8_STAGE(PG8_SA(0, 0), a2, v2[0]);
            PG8_WAIT_V(8); PG8_WAIT_L(0); PG8_BAR; PG8_MMA(1, 0, At, B0); PG8_MMA(1, 1, At, B1); PG8_BAR; PG8_SCHED;
            PG8_LDB(B0, 1, 0); PG8_LDB(B1, 1, 1); PG8_SCHED; PG8_LDA(At, 1, 0); PG8_STAGE(PG8_SA(0, 1), a2, v2[1]);
            PG8_WAIT_V(8); PG8_WAIT_L(0); PG8_BAR; PG8_MMA(0, 0, At, B0); PG8_MMA(0, 1, At, B1); PG8_BAR; PG8_SCHED;
            PG8_LDA(At, 1, 1); PG8_STAGE(PG8_SB(1, 0), b3, voffB); PG8_STAGE(PG8_SB(1, 1), b3 + hstepB, voffB); PG8_STAGE(PG8_SA(1, 0), a3, v2[0]);
            PG8_WAIT_V(8); PG8_WAIT_L(0); PG8_BAR; PG8_MMA(1, 0, At, B0); PG8_MMA(1, 1, At, B1); PG8_BAR; PG8_SCHED;
        }
        if constexpr (ALIGN_EPI) { if (wr == 0) PG8_BAR; }
        asm volatile("s_nop 15\n\ts_nop 15" : "+v"(acc[0][0][0][0]), "+v"(acc[0][0][0][1]), "+v"(acc[0][0][1][0]), "+v"(acc[0][0][1][1]), "+v"(acc[0][0][2][0]), "+v"(acc[0][0][2][1]), "+v"(acc[0][0][3][0]), "+v"(acc[0][0][3][1]), "+v"(acc[0][1][0][0]), "+v"(acc[0][1][0][1]), "+v"(acc[0][1][1][0]), "+v"(acc[0][1][1][1]), "+v"(acc[0][1][2][0]), "+v"(acc[0][1][2][1]), "+v"(acc[0][1][3][0]), "+v"(acc[0][1][3][1]) :: "memory");
        asm volatile("" : "+v"(acc[1][0][0][0]), "+v"(acc[1][0][0][1]), "+v"(acc[1][0][1][0]), "+v"(acc[1][0][1][1]), "+v"(acc[1][0][2][0]), "+v"(acc[1][0][2][1]), "+v"(acc[1][0][3][0]), "+v"(acc[1][0][3][1]), "+v"(acc[1][1][0][0]), "+v"(acc[1][1][0][1]), "+v"(acc[1][1][1][0]), "+v"(acc[1][1][1][1]), "+v"(acc[1][1][2][0]), "+v"(acc[1][1][2][1]), "+v"(acc[1][1][3][0]), "+v"(acc[1][1][3][1]) :: "memory");
        if constexpr (!Epi::AFTER_DRAIN) { E(acc, cur, wr, wc, fr, fq, lds); }
        asm volatile("" ::: "memory");
        if (!has_next) break;
#pragma unroll
        for (int a = 0; a < 2; ++a)
#pragma unroll
            for (int b = 0; b < 2; ++b)
#pragma unroll
                for (int m = 0; m < 4; ++m)
#pragma unroll
                    for (int n = 0; n < 2; ++n) acc[a][b][m][n] = (f32x4){0.f, 0.f, 0.f, 0.f};
        cur = nxt; cA = nA; cB = nB; ++ui; if (cur.nt > 0) { nt = cur.nt; asm volatile("" : "+s"(nt)); }
        if (GATHER) {
#pragma unroll
            for (int h = 0; h < 2; ++h)
#pragma unroll
                for (int i = 0; i < 2; ++i) vo[h][i] = nvo[h][i];
        }
        if constexpr (ALIGN_EPI) { if (wr == 1) PG8_BAR; }
    }
    PG8_WAIT_V(0);
    if constexpr (!ALIGN_EPI) { if (wr == 0) PG8_BAR; }
    PG8_BAR;
    asm volatile("" ::: "memory");
    if constexpr (Epi::AFTER_DRAIN) { E.fused(acc, cur, wr, wc, fr, fq, lds, wid, lane); }
    asm volatile("" ::: "memory");
#undef PG8_SA
#undef PG8_SB
#undef PG8_STAGE
#undef PG8_LDA
#undef PG8_LD16
#undef PG8_CAT8
#undef PG8_LDB
#undef PG8_MMA
#undef PG8_WAIT_V
#undef PG8_WAIT_L
#undef PG8_BAR
#undef PG8_SCHED
#undef PG8_SETVO
}
}
using pg8::Unit;

struct SchedStd : pg8::StaticOrder {
    const char* A; const char* Bt; size_t astep, bstep;
    __device__ __forceinline__ const char* abase(const Unit& u) const { return A + (size_t)u.pm * astep; }
    __device__ __forceinline__ const char* bbase(const Unit& u) const { return Bt + (size_t)u.pn * bstep; }
    __device__ __forceinline__ int tok(const Unit&, int rl) const { return rl; }
};
__device__ __forceinline__ int moe_cnt(const unsigned* cntw, int e) { return (int)__builtin_amdgcn_readfirstlane((int)__hip_atomic_load(cntw + 64 * e, __ATOMIC_RELAXED, __HIP_MEMORY_SCOPE_AGENT)); }
__device__ __forceinline__ int moe_total_tiles(const unsigned* cntw) { int t = 0;
#pragma unroll
    for (int e = 0; e < 8; ++e) t += (moe_cnt(cntw, e) + 255) >> 8; return t; }
constexpr int MOE_TT_OFF = MISC_OFF + 1024, MOE_TT_N = 160;
typedef int i32x4 __attribute__((ext_vector_type(4)));
__device__ __forceinline__ void moe_table_build(LAS unsigned char* lds, const unsigned* cntw) {
    int tid = threadIdx.x; asm volatile("" : "+v"(tid));
    if (tid <= MOE_TT_N) { int c[8];
#pragma unroll
        for (int j = 0; j < 8; ++j) c[j] = (int)__hip_atomic_load(cntw + 64 * j, __ATOMIC_RELAXED, __HIP_MEMORY_SCOPE_AGENT);
        int acc = 0, e = 0, tse = 0, cn = 1;
#pragma unroll
        for (int j = 0; j < 8; ++j) { if (tid >= acc) { e = j; tse = acc; cn = c[j]; } acc += (c[j] + 255) >> 8; }
        *(LAS i32x4*)(lds + MOE_TT_OFF + 16 * tid) = (tid < MOE_TT_N) ? (i32x4){e, (tid - tse) * 256, cn, 0} : (i32x4){acc, 0, 0, 0}; }
    __syncthreads();
}
__device__ __forceinline__ int moe_table_tiles(LAS unsigned char* lds) { return __builtin_amdgcn_readfirstlane(*(const LAS int*)(lds + MOE_TT_OFF + 16 * MOE_TT_N)); }
__device__ __forceinline__ void moe_fill(LAS const unsigned char* tt, Unit& u) { const i32x4 v = *(const LAS i32x4*)(tt + 16 * u.pm); u.e = v.x; u.p0 = v.y; u.cn = v.z; }
struct SchedMoeGu : pg8::StaticOrder {
    const char* XB; const char* W; LAS const unsigned char* tt; const int* idxt;
    __device__ __forceinline__ bool next(int i, Unit& u) const { if (!pg8::StaticOrder::next(i, u)) return false; moe_fill(tt, u); return true; }
    __device__ __forceinline__ const char* abase(const Unit&) const { return XB; }
    __device__ __forceinline__ const char* bbase(const Unit& u) const { return W + (size_t)u.e * ((size_t)2 * FF * D * MESZ) + (size_t)u.pn * (256 * D * MESZ); }
    __device__ __forceinline__ int tok(const Unit& u, int rl) const { const int pos = u.p0 + rl; return idxt[u.e * M + (pos < u.cn ? pos : u.cn - 1)]; }
    __device__ __forceinline__ void tok4(const Unit& u, int r0, int r1, int (&out)[4]) const {
        const int* base = idxt + u.e * M; const int lim = u.cn - 1;
        int p[4] = {u.p0 + r0, u.p0 + r1, u.p0 + 128 + r0, u.p0 + 128 + r1};
#pragma unroll
        for (int i = 0; i < 4; ++i) p[i] = (p[i] < lim ? p[i] : lim) * 4;
        asm volatile("global_load_dword %0, %4, %8\n\tglobal_load_dword %1, %5, %8\n\tglobal_load_dword %2, %6, %8\n\tglobal_load_dword %3, %7, %8\n\ts_waitcnt vmcnt(0)"
                     : "=&v"(out[0]), "=&v"(out[1]), "=&v"(out[2]), "=&v"(out[3]) : "v"(p[0]), "v"(p[1]), "v"(p[2]), "v"(p[3]), "s"(base) : "memory");
    }
};
struct SchedMoeDn {
    const char* A; const char* W; LAS const unsigned char* tt; int RT, G, c;
    static constexpr int KTW = MOE_FP8 ? 22 : 44, KT0 = MOE_FP8 ? 10 : 22, KT1 = MOE_FP8 ? 12 : 22, RT0 = 128;
    __device__ __forceinline__ void init(int RT_, int G_, int c_) { RT = RT_; G = G_; c = c_; }
    __device__ __forceinline__ bool next(int i, Unit& u) const {
        const int L = i * G + c; const int nw = RT0 * 4;
        if (L < nw) { pg8::StaticOrder so; so.init(RT0, 4, G, c); if (!so.next(i, u)) return false; u.nt = KTW; }
        else { const int L2 = L - nw, n2 = (RT - RT0) * 8; if (L2 >= n2) return false;
            u.pm = RT0 + (L2 >> 3); u.pn = L2 & 7; u.nt = (u.pn >> 2) ? KT1 : KT0; }
        moe_fill(tt, u); return true;
    }
    __device__ __forceinline__ int kofs(const Unit& u) const { return (u.pm >= RT0 && (u.pn >> 2)) ? KT0 * 128 : 0; }
    __device__ __forceinline__ const char* abase(const Unit& u) const { return A + (size_t)u.pm * (256 * (size_t)FF * MESZ) + kofs(u); }
    __device__ __forceinline__ const char* bbase(const Unit& u) const { return W + (size_t)u.e * ((size_t)D * FF * MESZ) + (size_t)(u.pn & 3) * (256 * (size_t)FF * MESZ) + kofs(u); }
    __device__ __forceinline__ int tok(const Unit&, int rl) const { return rl; }
};

#define EPI_ROWS(ai, m) for (int ai = 0; ai < 2; ++ai) _Pragma("unroll") for (int m = 0; m < 4; ++m)
__device__ __forceinline__ float sum4(f32x4 v) { return (v.x + v.y) + (v.z + v.w); }
__device__ __forceinline__ float xsum16(float s) { return s + __uint_as_float((unsigned)__builtin_amdgcn_ds_swizzle((int)__float_as_uint(s), 0x401F)); }
__device__ __forceinline__ float xsum32(float s) { auto r = __builtin_amdgcn_permlane32_swap(__float_as_uint(s), __float_as_uint(s), false, false); return __uint_as_float(r[0]) + __uint_as_float(r[1]); }
__device__ __forceinline__ float xmax32(float s) { auto r = __builtin_amdgcn_permlane32_swap(__float_as_uint(s), __float_as_uint(s), false, false); return fmaxf(__uint_as_float(r[0]), __uint_as_float(r[1])); }
__device__ __forceinline__ float qsum(float s) { return xsum32(xsum16(s)); }
#define DPP_ROR_ADD(s, n) ((s) + __uint_as_float(__builtin_amdgcn_update_dpp(0u, __float_as_uint(s), 0x120 + (n), 0xf, 0xf, false)))
__device__ __forceinline__ float wave_sum(float s) { s = DPP_ROR_ADD(s, 8); s = DPP_ROR_ADD(s, 4); s = DPP_ROR_ADD(s, 2); s = DPP_ROR_ADD(s, 1); return xsum32(xsum16(s)); }
__device__ __forceinline__ u32x2 pack8_f8(f32x4 a, f32x4 b) { int w0 = 0, w1 = 0; w0 = __builtin_amdgcn_cvt_pk_fp8_f32(a.x, a.y, w0, false); w0 = __builtin_amdgcn_cvt_pk_fp8_f32(a.z, a.w, w0, true);
    w1 = __builtin_amdgcn_cvt_pk_fp8_f32(b.x, b.y, w1, false); w1 = __builtin_amdgcn_cvt_pk_fp8_f32(b.z, b.w, w1, true); return (u32x2){(unsigned)w0, (unsigned)w1}; }
__device__ __forceinline__ unsigned gate_q(float a) { return (unsigned)__builtin_fmaxf(a * 255.0f + 0.5f, 1.0f); }
__device__ __forceinline__ unsigned gate_q4(f32x4 a) { return gate_q(a.x) | (gate_q(a.y) << 8) | (gate_q(a.z) << 16) | (gate_q(a.w) << 24); }
__device__ __forceinline__ f32x4 gate_f4(unsigned w) { return (f32x4){(float)(w & 255u), (float)((w >> 8) & 255u), (float)((w >> 16) & 255u), (float)(w >> 24)}; }
__device__ __forceinline__ void st_wt(void* p, u32x4 v) { asm volatile("global_store_dwordx4 %0, %1, off sc1\n\ts_nop 1" :: "v"(p), "v"(v) : "memory"); }
__device__ __forceinline__ f32x4 ld_nt(const float* p) { return __builtin_nontemporal_load((const f32x4*)p); }
__device__ __forceinline__ u32x4 ld_nt(const bf16_t* p) { return __builtin_nontemporal_load((const u32x4*)p); }
__device__ __forceinline__ u32x4 pack8(f32x4 a, f32x4 b) { u32x4 w; w.x = cvt_pk_bf16(a.x, a.y); w.y = cvt_pk_bf16(a.z, a.w); w.z = cvt_pk_bf16(b.x, b.y); w.w = cvt_pk_bf16(b.z, b.w); return w; }

struct EpiG1 {
    static constexpr bool AFTER_DRAIN = false;
    const float* xssp; bf16_t *U, *Vg, *CQ, *CKV, *G; float *vstp, *cqp, *ckvp, *KR, *krss; const float* gk; const float *cosT, *sinT;
    __device__ __forceinline__ void operator()(f32x4 (&acc)[2][2][4][2], const Unit& u, int wr, int wc, int fr, int fq, LAS unsigned char*) const {
        int row0 = u.pm * 256 + wr * 64 + fr; asm volatile("" : "+v"(row0)); const int t = u.pn; const int pc = 32 * wc + 8 * fq;
        float rs[2][4]; { f32x4 xs_[2][4];
#pragma unroll
        EPI_ROWS(ai, m) { const int r = row0 + ai * 128 + m * 16; xs_[ai][m] = *(const f32x4*)(xssp + (size_t)r * 4); }
        __builtin_amdgcn_sched_barrier(0);
#pragma unroll
        EPI_ROWS(ai, m) rs[ai][m] = frsq(sum4(xs_[ai][m]) * (1.0f / D) + EPS); }
        if (t < 4) {
#pragma unroll
            EPI_ROWS(ai, m) { const int r = row0 + ai * 128 + m * 16; const float s = rs[ai][m];
#pragma unroll
                for (int bj = 0; bj < 2; ++bj) { f32x4 a = acc[ai][bj][m][0] * s, b = acc[ai][bj][m][1] * s;
                    a = gelu4(a); b = gelu4(b);
                    st_wt(U + (size_t)r * D + 256 * t + 128 * bj + pc, pack8(a, b)); } }
        } else if (t < 8) {
#pragma unroll
            EPI_ROWS(ai, m) { const int r = row0 + ai * 128 + m * 16; const float s = rs[ai][m]; float s1 = 0.f, s2 = 0.f;
#pragma unroll
                for (int bj = 0; bj < 2; ++bj) { f32x4 a = acc[ai][bj][m][0] * s, b = acc[ai][bj][m][1] * s;
                    a = gelu4(a); b = gelu4(b); s1 += sum4(a) + sum4(b); s2 += sum4(a * a) + sum4(b * b);
                    st_wt(Vg + (size_t)r * D + 256 * (t - 4) + 128 * bj + pc, pack8(a, b)); }
                s1 = qsum(s1); s2 = qsum(s2);
                if (fq == 0) *(f32x2*)(vstp + ((size_t)r * 16 + (t - 4) * 4 + wc) * 2) = (f32x2){s1, s2}; }
        } else if (t < 11) {
            bf16_t* O = (t < 10) ? CQ : CKV; const int ldo = (t < 10) ? QL : KVL; const int cb = (t < 10) ? 256 * (t - 8) : 0;
            float* pp = (t < 10) ? cqp : ckvp; const int np = (t < 10) ? 8 : 4; const int pi = (t < 10) ? (t - 8) * 4 + wc : wc;
#pragma unroll
            EPI_ROWS(ai, m) { const int r = row0 + ai * 128 + m * 16; const float s = rs[ai][m]; float s2 = 0.f;
#pragma unroll
                for (int bj = 0; bj < 2; ++bj) { f32x4 a = acc[ai][bj][m][0] * s, b = acc[ai][bj][m][1] * s;
#pragma unroll
                    for (int i = 0; i < 4; ++i) s2 += a[i] * a[i] + b[i] * b[i];
                    st_wt(O + (size_t)r * ldo + cb + 128 * bj + pc, pack8(a, b)); }
                s2 = qsum(s2);
                if (fq == 0) pp[(size_t)r * np + pi] = s2; }
        } else if (t == 11) {
            if (wc == 0) {
                const f32x4 g0 = *(const f32x4*)(gk + 64 + 4 * fq), g1 = *(const f32x4*)(gk + 80 + 4 * fq);
#pragma unroll
              for (int ai = 0; ai < 2; ++ai) { f32x4 cc_[4], ss_[4];
#pragma unroll
                for (int m = 0; m < 4; ++m) { const int pos = (row0 + ai * 128 + m * 16) & (SEQ - 1); cc_[m] = *(const f32x4*)(cosT + pos * 16 + 4 * fq); ss_[m] = *(const f32x4*)(sinT + pos * 16 + 4 * fq); }
                __builtin_amdgcn_sched_barrier(0);
#pragma unroll
                for (int m = 0; m < 4; ++m) { const int r = row0 + ai * 128 + m * 16; const float s = rs[ai][m];
                    const f32x4 a0 = acc[ai][0][m][0] * s, a1 = acc[ai][0][m][1] * s;
                    float s2 = sum4(a0 * a0) + sum4(a1 * a1); s2 = qsum(s2);
                    const f32x4 c = cc_[m], sn = ss_[m];
                    const f32x4 x0 = a0 * g0, x1 = a1 * g1;
                    *(f32x4*)(KR + (size_t)r * 32 + 4 * fq) = x0 * c - x1 * sn;
                    *(f32x4*)(KR + (size_t)r * 32 + 16 + 4 * fq) = x1 * c + x0 * sn;
                    if (fq == 0) krss[r] = s2; } }
            }
        } else {
#pragma unroll
            EPI_ROWS(ai, m) { const int r = row0 + ai * 128 + m * 16; const float s = rs[ai][m];
                u32x4 qv;
                { const f32x4 a = sigm4(acc[ai][0][m][0] * s), b = sigm4(acc[ai][0][m][1] * s); qv.x = gate_q4(a); qv.y = gate_q4(b); }
                { const f32x4 a = sigm4(acc[ai][1][m][0] * s), b = sigm4(acc[ai][1][m][1] * s); qv.z = gate_q4(a); qv.w = gate_q4(b); }
                st_wt((unsigned char*)G + (size_t)r * 2048 + 256 * (t - 12) + 64 * wc + 16 * fq, qv); }
        }
    }
};


struct EpiRaw {
    static constexpr bool AFTER_DRAIN = false;
    bf16_t* O; int ldc;
    __device__ __forceinline__ void operator()(f32x4 (&acc)[2][2][4][2], const Unit& u, int wr, int wc, int fr, int fq, LAS unsigned char*) const {
        int row0 = u.pm * 256 + wr * 64 + fr; asm volatile("" : "+v"(row0)); const int pc = 32 * wc + 8 * fq;
#pragma unroll
        EPI_ROWS(ai, m) { const int r = row0 + ai * 128 + m * 16;
#pragma unroll
            for (int bj = 0; bj < 2; ++bj) *(u32x4*)(O + (size_t)r * ldc + 256 * u.pn + 128 * bj + pc) = pack8(acc[ai][bj][m][0], acc[ai][bj][m][1]); }
    }
};

struct EpiQ {
    static constexpr bool AFTER_DRAIN = false;
    const float* cqp; const float* gq; const float *cosT, *sinT; bf16_t* Q;
    __device__ __forceinline__ void operator()(f32x4 (&acc)[2][2][4][2], const Unit& u, int wr, int wc, int fr, int fq, LAS unsigned char* lds) const {
        LAS float* P = (LAS float*)(lds + XCH_OFF); asm volatile("" : "+v"(fq));
        int row0 = u.pm * 256 + wr * 64 + fr; asm volatile("" : "+v"(row0)); const int head = 2 * u.pn + (wc >> 1), half = wc & 1;
        float ps[2][4], rsq_[2][4];
#pragma unroll
        for (int am = 0; am < 4; ++am) { const int ai = am >> 1; f32x4 c0_[2], c1_[2];
#pragma unroll
            for (int h_ = 0; h_ < 2; ++h_) { const int r = row0 + ai * 128 + (2 * (am & 1) + h_) * 16; c0_[h_] = *(const f32x4*)(cqp + (size_t)r * 8); c1_[h_] = *(const f32x4*)(cqp + (size_t)r * 8 + 4); }
            __builtin_amdgcn_sched_barrier(0);
#pragma unroll
            for (int h_ = 0; h_ < 2; ++h_) rsq_[ai][2 * (am & 1) + h_] = frsq((sum4(c0_[h_]) + sum4(c1_[h_])) * (1.0f / QL) + EPS); }
#pragma unroll
        EPI_ROWS(ai, m) {
            const float rs = rsq_[ai][m];
            f32x4 a = acc[ai][0][m][0] * rs, b = acc[ai][0][m][1] * rs; acc[ai][0][m][0] = a; acc[ai][0][m][1] = b;
            float s = sum4(a * a) + sum4(b * b);
            if (half == 0) { f32x4 c = acc[ai][1][m][0] * rs, d = acc[ai][1][m][1] * rs; acc[ai][1][m][0] = c; acc[ai][1][m][1] = d; s += sum4(c * c) + sum4(d * d); }
            s = qsum(s); ps[ai][m] = s;
            if (fq == 0) P[(ai * 128 + wr * 64 + m * 16 + fr) * 4 + wc] = s; }
        LDS_WAIT(); RAW_BAR();
        const f32x4 gn0 = *(const f32x4*)(gq + 32 * half + 8 * fq), gn1 = *(const f32x4*)(gq + 32 * half + 8 * fq + 4);
        const f32x4 gr0 = *(const f32x4*)(gq + 64 + 4 * fq), gr1 = *(const f32x4*)(gq + 80 + 4 * fq);
#pragma unroll
        for (int am = 0; am < 4; ++am) { const int ai = am >> 1; f32x4 cc_[2], ss_[2];
            if (half == 0) {
#pragma unroll
                for (int h_ = 0; h_ < 2; ++h_) { const int pos = (row0 + ai * 128 + (2 * (am & 1) + h_) * 16) & (SEQ - 1); cc_[h_] = *(const f32x4*)(cosT + pos * 16 + 4 * fq); ss_[h_] = *(const f32x4*)(sinT + pos * 16 + 4 * fq); }
            }
            __builtin_amdgcn_sched_barrier(0);
#pragma unroll
          for (int h_ = 0; h_ < 2; ++h_) { const int m = 2 * (am & 1) + h_; const int r = row0 + ai * 128 + m * 16; const int rl = ai * 128 + wr * 64 + m * 16 + fr;
            const float oth = P[rl * 4 + (wc ^ 1)];
            const float rstd = frsq((ps[ai][m] + oth) * (1.0f / DQK) + EPS) * C2;
            bf16_t* qrow = Q + (size_t)r * (NH * DQK) + head * DQK;
            *(u32x4*)(qrow + 32 * half + 8 * fq) = pack8(acc[ai][0][m][0] * gn0 * rstd, acc[ai][0][m][1] * gn1 * rstd);
            if (half == 0) {
                const f32x4 c = cc_[h_], sn = ss_[h_];
                const f32x4 x0 = acc[ai][1][m][0] * gr0, x1 = acc[ai][1][m][1] * gr1;
                const f32x4 o1 = (x0 * c - x1 * sn) * rstd, o2 = (x1 * c + x0 * sn) * rstd;
                *(u32x2*)(qrow + 64 + 4 * fq) = (u32x2){cvt_pk_bf16(o1.x, o1.y), cvt_pk_bf16(o1.z, o1.w)};
                *(u32x2*)(qrow + 80 + 4 * fq) = (u32x2){cvt_pk_bf16(o2.x, o2.y), cvt_pk_bf16(o2.z, o2.w)}; } } }
    }
};

struct EpiKV {
    static constexpr bool AFTER_DRAIN = false;
    const float* ckvp; const float* krss; const float* KR; const float* gk; bf16_t *Kt, *Vt;
    __device__ __forceinline__ void operator()(f32x4 (&acc)[2][2][4][2], const Unit& u, int wr, int wc, int fr, int fq, LAS unsigned char*) const {
        int row0 = u.pm * 256 + wr * 64 + fr; asm volatile("" : "+v"(row0)); const int head = 2 * u.pn + (wc >> 1), isv = wc & 1;
        asm volatile("" : "+v"(fq));
        float rsv[2][4], kss[2][4];
#pragma unroll
        for (int ai = 0; ai < 2; ++ai) { f32x4 xs_[4];
#pragma unroll
            for (int m = 0; m < 4; ++m) { const int r = row0 + ai * 128 + m * 16; xs_[m] = *(const f32x4*)(ckvp + (size_t)r * 4); kss[ai][m] = isv ? 0.f : krss[r]; }
            __builtin_amdgcn_sched_barrier(0);
#pragma unroll
            for (int m = 0; m < 4; ++m) rsv[ai][m] = frsq(sum4(xs_[m]) * (1.0f / KVL) + EPS);
            __builtin_amdgcn_sched_barrier(0); }
        f32x4 g[2][2];
#pragma unroll
        for (int bj = 0; bj < 2; ++bj) { g[bj][0] = *(const f32x4*)(gk + 32 * bj + 8 * fq); g[bj][1] = *(const f32x4*)(gk + 32 * bj + 8 * fq + 4); }
#pragma unroll
        EPI_ROWS(ai, m) { const int r = row0 + ai * 128 + m * 16; const int b = r >> 11, sq = r & (SEQ - 1), tile = sq >> 6, key = sq & 63;
            const float rs = rsv[ai][m];
            const size_t bht = (size_t)(b * NH + head) * 32 + tile;
            if (isv) {
#pragma unroll
                for (int bj = 0; bj < 2; ++bj) st_wt(Vt + (bht * 2 + bj) * 2048 + key * 32 + 8 * fq, pack8(acc[ai][bj][m][0] * rs, acc[ai][bj][m][1] * rs));
            } else {
                f32x4 v[2][2]; float s_ = 0.f;
#pragma unroll
                for (int bj = 0; bj < 2; ++bj)
#pragma unroll
                    for (int n = 0; n < 2; ++n) { v[bj][n] = acc[ai][bj][m][n] * rs; s_ += sum4(v[bj][n] * v[bj][n]); }
                s_ = qsum(s_) + kss[ai][m];
                const float rstd = frsq(s_ * (1.0f / DQK) + EPS);
#pragma unroll
                for (int bj = 0; bj < 2; ++bj) st_wt(Kt + (bht * 12 + 4 * bj + fq) * 512 + key * 8, pack8(v[bj][0] * g[bj][0] * rstd, v[bj][1] * g[bj][1] * rstd));
                const f32x4 k0 = *(const f32x4*)(KR + (size_t)r * 32 + 8 * fq), k1 = *(const f32x4*)(KR + (size_t)r * 32 + 8 * fq + 4);
                st_wt(Kt + (bht * 12 + 8 + fq) * 512 + key * 8, pack8(k0 * rstd, k1 * rstd));
            } }
    }
};

struct EpiProjF {
    static constexpr bool AFTER_DRAIN = false;
    const bf16_t* G; bf16_t* MG;
    __device__ __forceinline__ void mid(f32x4 (&acc)[2][2][4][2], const Unit& u, int wr, int wc, int fr, int fq) const {
        int row0 = u.pm * 256 + wr * 64 + fr; asm volatile("" : "+v"(row0)); const int col0 = u.pn * 256 + 32 * wc + 8 * fq;
        const unsigned char* G8 = (const unsigned char*)G;
        u32x2 ga_[2][4][2], gb_[2][4][2];
#pragma unroll
        EPI_ROWS(ai, m) { const int r = row0 + ai * 128 + m * 16;
#pragma unroll
            for (int bj = 0; bj < 2; ++bj) { const int c = col0 + 128 * bj; ga_[ai][m][bj] = *(const u32x2*)(G8 + (size_t)r * 2048 + c); gb_[ai][m][bj] = *(const u32x2*)(G8 + (size_t)r * 2048 + 1024 + c); } }
        __builtin_amdgcn_sched_barrier(0);
#pragma unroll
        EPI_ROWS(ai, m) {
#pragma unroll
            for (int bj = 0; bj < 2; ++bj) { const u32x2 ga = ga_[ai][m][bj], gb = gb_[ai][m][bj];
                const f32x4 a0_ = gate_f4(ga.x), a1_ = gate_f4(ga.y), b0_ = gate_f4(gb.x), b1_ = gate_f4(gb.y);
                const f32x4 r0 = {a0_.x * frcp(b0_.x), a0_.y * frcp(b0_.y), a0_.z * frcp(b0_.z), a0_.w * frcp(b0_.w)};
                const f32x4 r1 = {a1_.x * frcp(b1_.x), a1_.y * frcp(b1_.y), a1_.z * frcp(b1_.z), a1_.w * frcp(b1_.w)};
                acc[ai][bj][m][0] = acc[ai][bj][m][0] * r0; acc[ai][bj][m][1] = acc[ai][bj][m][1] * r1; } }
        __builtin_amdgcn_sched_barrier(0);
    }
    __device__ __forceinline__ void operator()(f32x4 (&acc)[2][2][4][2], const Unit& u, int wr, int wc, int fr, int fq, LAS unsigned char*) const {
        int row0 = u.pm * 256 + wr * 64 + fr; asm volatile("" : "+v"(row0)); const int col0 = u.pn * 256 + 32 * wc + 8 * fq;
        const unsigned char* G8 = (const unsigned char*)G;
        u32x2 gb_[2][4][2];
#pragma unroll
        EPI_ROWS(ai, m) { const int r = row0 + ai * 128 + m * 16;
#pragma unroll
            for (int bj = 0; bj < 2; ++bj) gb_[ai][m][bj] = *(const u32x2*)(G8 + (size_t)r * 2048 + 1024 + col0 + 128 * bj); }
        __builtin_amdgcn_sched_barrier(0);
#pragma unroll
        EPI_ROWS(ai, m) { const int r = row0 + ai * 128 + m * 16;
#pragma unroll
            for (int bj = 0; bj < 2; ++bj) { const int c = col0 + 128 * bj; const u32x2 gb = gb_[ai][m][bj];
                const f32x4 g0 = gate_f4(gb.x) * (1.0f / 255.0f), g1 = gate_f4(gb.y) * (1.0f / 255.0f);
                *(u32x4*)(MG + (size_t)r * D + c) = pack8(acc[ai][bj][m][0] * g0, acc[ai][bj][m][1] * g1); } }
    }
};

struct EpiRes {
    static constexpr bool AFTER_DRAIN = true;
    const float* res; float* out; bf16_t* XB; float* xssp; unsigned char* XB8;
    __device__ __forceinline__ void operator()(f32x4 (&)[2][2][4][2], const Unit&, int, int, int, int, LAS unsigned char*) const {}
    __device__ __forceinline__ void fused(f32x4 (&acc)[2][2][4][2], const Unit& u, int wr, int wc, int fr, int fq, LAS unsigned char* lds, int wid, int lane) const {
        LAS float* P = (LAS float*)lds;
        int row0 = u.pm * 256 + wr * 64 + fr; asm volatile("" : "+v"(row0)); const int col0 = u.pn * 256 + 32 * wc + 8 * fq;
#if RES_BF16
        u32x4 xr_[2][4][2];
#pragma unroll
        EPI_ROWS(ai, m) { const int r = row0 + ai * 128 + m * 16;
#pragma unroll
            for (int bj = 0; bj < 2; ++bj) xr_[ai][m][bj] = *(const u32x4*)(XB + (size_t)r * D + col0 + 128 * bj); }
        __builtin_amdgcn_sched_barrier(0);
#pragma unroll
        EPI_ROWS(ai, m) { const int r = row0 + ai * 128 + m * 16; float s = 0.f;
#pragma unroll
            for (int bj = 0; bj < 2; ++bj) { const size_t o = (size_t)r * D + col0 + 128 * bj; const u32x4 xr = xr_[ai][m][bj];
                const f32x4 a = (f32x4){bf_lo(xr.x), bf_hi(xr.x), bf_lo(xr.y), bf_hi(xr.y)} + acc[ai][bj][m][0], b = (f32x4){bf_lo(xr.z), bf_hi(xr.z), bf_lo(xr.w), bf_hi(xr.w)} + acc[ai][bj][m][1];
                *(u32x4*)(XB + o) = pack8(a, b); if (XB8) *(u32x2*)(XB8 + o) = pack8_f8(a, b);
                s += sum4(a * a) + sum4(b * b); }
            s = qsum(s);
            if (fq == 0) P[(ai * 128 + wr * 64 + m * 16 + fr) * 4 + wc] = s; }
#else
#pragma unroll
        EPI_ROWS(ai, m) { const int r = row0 + ai * 128 + m * 16; float s = 0.f;
#pragma unroll
            for (int bj = 0; bj < 2; ++bj) { const size_t o = (size_t)r * D + col0 + 128 * bj;
#if RES_BF16
                const u32x4 xr = *(const u32x4*)(XB + o);
                const f32x4 a = (f32x4){bf_lo(xr.x), bf_hi(xr.x), bf_lo(xr.y), bf_hi(xr.y)} + acc[ai][bj][m][0], b = (f32x4){bf_lo(xr.z), bf_hi(xr.z), bf_lo(xr.w), bf_hi(xr.w)} + acc[ai][bj][m][1];
#else
                const f32x4 a = ld_nt(res + o) + acc[ai][bj][m][0], b = ld_nt(res + o + 4) + acc[ai][bj][m][1];
                *(f32x4*)(out + o) = a; *(f32x4*)(out + o + 4) = b;
#endif
                *(u32x4*)(XB + o) = pack8(a, b); if (XB8) *(u32x2*)(XB8 + o) = pack8_f8(a, b);
                s += sum4(a * a) + sum4(b * b); }
            s = qsum(s);
            if (fq == 0) P[(ai * 128 + wr * 64 + m * 16 + fr) * 4 + wc] = s; }
#endif
        LDS_WAIT(); RAW_BAR();
        const int tid = wid * 64 + lane;
        if (tid < 256) { const f32x4 v = *(const LAS f32x4*)(P + tid * 4); xssp[(size_t)(u.pm * 256 + tid) * 4 + u.pn] = sum4(v); }
    }
};

template <bool MOE> struct EpiGU {
    static constexpr bool AFTER_DRAIN = false;
    const float* xssp; bf16_t* ACT; const float* idxr;
    __device__ __forceinline__ void operator()(f32x4 (&acc)[2][2][4][2], const Unit& u, int wr, int wc, int fr, int fq, LAS unsigned char*) const {
        int row0 = u.pm * 256 + wr * 64 + fr; asm volatile("" : "+v"(row0)); const int col0 = u.pn * 128 + 32 * wc + 8 * fq;
        const int e = u.e, cn = u.cn; int p0 = u.p0 + wr * 64 + fr; asm volatile("" : "+v"(p0));
#if MOE_FP8 && ACT8_WIDE
        if (MOE) {
            float rw_[2][4];
#pragma unroll
            EPI_ROWS(ai, m) { const int pos = p0 + ai * 128 + m * 16; rw_[ai][m] = idxr[e * M + (pos < cn ? pos : cn - 1)]; }
            __builtin_amdgcn_sched_barrier(0);
#pragma unroll
            for (int ai = 0; ai < 2; ++ai)
#pragma unroll
                for (int mp = 0; mp < 2; ++mp) { u32x2 pk[2];
#pragma unroll
                    for (int h = 0; h < 2; ++h) { const int m = 2 * mp + h; const int pos = p0 + ai * 128 + m * 16; const float rs = pos < cn ? rw_[ai][m] : (1.0f / W8_SCALE);
                        f32x4 a = acc[ai][0][m][0] * rs, b = acc[ai][0][m][1] * rs; const f32x4 c = acc[ai][1][m][0] * rs, d = acc[ai][1][m][1] * rs;
                        a = a * sigm4(a) * c; b = b * sigm4(b) * d; pk[h] = pack8_f8(a, b); }
                    const auto s0 = __builtin_amdgcn_permlane16_swap(pk[0].x, pk[1].x, false, false), s1 = __builtin_amdgcn_permlane16_swap(pk[0].y, pk[1].y, false, false);
                    const int r = row0 + ai * 128 + (2 * mp + (fq & 1)) * 16;
                    *(u32x4*)((unsigned char*)ACT + (size_t)r * FF + col0 - 8 * (fq & 1)) = (u32x4){s0[0], s1[0], s0[1], s1[1]}; }
            return; }
#endif
        float rsv[2][4]; { f32x4 xs_[2][4];
#pragma unroll
        EPI_ROWS(ai, m) { const int r = row0 + ai * 128 + m * 16;
            if (MOE) { const int pos = p0 + ai * 128 + m * 16; xs_[ai][m] = (f32x4){idxr[e * M + (pos < cn ? pos : cn - 1)], 0.f, 0.f, 0.f}; }
            else xs_[ai][m] = *(const f32x4*)(xssp + (size_t)r * 4); }
        __builtin_amdgcn_sched_barrier(0);
#pragma unroll
        EPI_ROWS(ai, m) { if (MOE) { const int pos = p0 + ai * 128 + m * 16; rsv[ai][m] = pos < cn ? xs_[ai][m].x : (1.0f / W8_SCALE); } else rsv[ai][m] = frsq(sum4(xs_[ai][m]) * (1.0f / D) + EPS); } }
#pragma unroll
        EPI_ROWS(ai, m) { const int r = row0 + ai * 128 + m * 16; const float rs = rsv[ai][m];
            f32x4 a = acc[ai][0][m][0] * rs, b = acc[ai][0][m][1] * rs; const f32x4 c = acc[ai][1][m][0] * rs, d = acc[ai][1][m][1] * rs;
            a = a * sigm4(a) * c; b = b * sigm4(b) * d;
            if (MOE && MOE_FP8) *(u32x2*)((unsigned char*)ACT + (size_t)r * FF + col0) = pack8_f8(a, b);
            else st_wt(ACT + (size_t)r * FF + col0, pack8(a, b)); }
    }
};

struct EpiMoeDn {
    static constexpr bool AFTER_DRAIN = false;
    bf16_t* Y; const float* idxw;
    __device__ __forceinline__ void operator()(f32x4 (&acc)[2][2][4][2], const Unit& u, int wr, int wc, int fr, int fq, LAS unsigned char*) const {
        const int e = u.e; int p0 = u.p0 + wr * 64 + fr; asm volatile("" : "+v"(p0)); const int cn = u.cn;
        const int col0 = (u.pn & 3) * 256 + 32 * wc + 8 * fq; const int row0 = u.pm * 256 + wr * 64 + fr;
        bf16_t* Yk = Y + (size_t)(u.pn >> 2) * SLOTS * D;
        float wv[2][4];
#pragma unroll
        EPI_ROWS(ai, m) { const int pos = p0 + ai * 128 + m * 16; wv[ai][m] = idxw[e * M + (pos < cn ? pos : cn - 1)]; }
        __builtin_amdgcn_sched_barrier(0);
#pragma unroll
        EPI_ROWS(ai, m) { const int pos = p0 + ai * 128 + m * 16;
            if (pos < cn) { const float w = wv[ai][m] * (1.0f / W8_SCALE); bf16_t* o = Yk + (size_t)(row0 + ai * 128 + m * 16) * D + col0;
#pragma unroll
                for (int bj = 0; bj < 2; ++bj) *(u32x4*)(o + 128 * bj) = pack8(acc[ai][bj][m][0] * w, acc[ai][bj][m][1] * w); } }
    }
};

#define XB_TMO      128
#define XB_XCNT(j)  (256  + 64 * (j))
#define XB_XSUB(j)  (1280 + 64 * (j))
#define XB_XGEN(j)  (2304 + 64 * (j))
#define XB_TOP      3328
#define XB_TOPGEN   3392
#define XCD_BAR_WORDS 3456
#define XB_SPIN_CAP (1u << 18)
__device__ __forceinline__ unsigned xb_ld(unsigned* p)              { return __hip_atomic_load(p, __ATOMIC_RELAXED, __HIP_MEMORY_SCOPE_AGENT); }
__device__ __forceinline__ unsigned xb_add(unsigned* p, unsigned v) { return __hip_atomic_fetch_add(p, v, __ATOMIC_RELAXED, __HIP_MEMORY_SCOPE_AGENT); }
__device__ __forceinline__ unsigned xb_xcc_id() { return (unsigned)__builtin_amdgcn_s_getreg((3 << 11) | 20) & 0xFu; }
#define XB_SPIN(cond, bar) do { unsigned _sp = 0; while (cond) { __builtin_amdgcn_s_sleep(1); \
    if ((++_sp & 255u) == 0u) { if (xb_ld(&(bar)[XB_TMO])) break; if (_sp > XB_SPIN_CAP) { atomicAdd(&(bar)[XB_TMO], 1u); break; } } } } while (0)
struct XcdBarrier { unsigned* bar; unsigned x; volatile LAS unsigned* st; };
__device__ __forceinline__ XcdBarrier xcd_barrier_post(unsigned* bar, volatile LAS unsigned* st) {
    XcdBarrier b; b.bar = bar; b.x = xb_xcc_id(); b.st = st;
    if (threadIdx.x == 0) (void)xb_add(&bar[XB_XCNT(b.x)], 1u);
    return b;
}
__device__ __forceinline__ void xcd_barrier_complete(unsigned* bar, unsigned x, unsigned& nloc, unsigned& nx) {
    const unsigned G = gridDim.x * gridDim.y * gridDim.z;
    unsigned sum, cnt, mine, sp = 0u;
    for (;;) {
        sum = 0u; cnt = 0u; mine = 0u;
#pragma unroll
        for (unsigned j = 0; j < 16; ++j) { const unsigned c = xb_ld(&bar[XB_XCNT(j)]); sum += c; cnt += (c > 0u) ? 1u : 0u; mine = (j == x) ? c : mine; }
        if (sum == G) break;
        __builtin_amdgcn_s_sleep(1);
        if ((++sp & 255u) == 0u) { if (xb_ld(&bar[XB_TMO])) break; if (sp > XB_SPIN_CAP) { atomicAdd(&bar[XB_TMO], 1u); break; } }
    }
    nloc = mine > 0u ? mine : 1u; nx = cnt > 0u ? cnt : 1u;
}
__device__ __forceinline__ void xcd_barrier(const XcdBarrier& b) {
    asm volatile("s_waitcnt vmcnt(0)" ::: "memory");
    __syncthreads();
    if (threadIdx.x == 0) {
        unsigned* bar = b.bar;
        __builtin_amdgcn_s_waitcnt(0);
        unsigned nloc = b.st[0], nx = b.st[1];
        if (nloc == 0u) { xcd_barrier_complete(bar, b.x, nloc, nx); b.st[0] = nloc; b.st[1] = nx; }
        const unsigned old = xb_add(&bar[XB_XSUB(b.x)], 1u);
        const unsigned gen = old / nloc;
        if (old + 1u == (gen + 1u) * nloc) {
            __builtin_amdgcn_fence(__ATOMIC_RELEASE, "agent");
            asm volatile("s_waitcnt vmcnt(0)" ::: "memory");
            const unsigned og = xb_add(&bar[XB_TOP], 1u);
            const unsigned tg = og / nx;
            if (og + 1u == (tg + 1u) * nx) xb_add(&bar[XB_TOPGEN], 1u);
            else XB_SPIN(xb_ld(&bar[XB_TOPGEN]) == tg, bar);
            __builtin_amdgcn_fence(__ATOMIC_ACQUIRE, "agent");
            xb_add(&bar[XB_XGEN(b.x)], 1u);
            asm volatile("s_waitcnt vmcnt(0)" ::: "memory");
        } else {
            XB_SPIN(xb_ld(&bar[XB_XGEN(b.x)]) == gen, bar);
            __builtin_amdgcn_fence(__ATOMIC_ACQUIRE, "agent");
            asm volatile("s_waitcnt vmcnt(0)" ::: "memory");
        }
    }
    __syncthreads();
}

#ifndef ATT_SUM_THR
#define ATT_SUM_THR 1.0e9f
#endif
namespace att {
constexpr int KSLOT = 12288, VSLOT = 8192, SLOT = KSLOT + VSLOT, NSLOT = 4, WSF_OFF = NSLOT * SLOT, OST_OFF = WSF_OFF + 2048, LDS_NEED = OST_OFF + 8 * 4096;
static_assert(LDS_NEED <= RING_BYTES, "attention LDS");
__device__ __forceinline__ void glds16(const void* gsrc, unsigned lds_dst) { unsigned keep;
    asm volatile("s_mov_b32 %0, m0\n\ts_mov_b32 m0, %2\n\ts_nop 0\n\tglobal_load_lds_dwordx4 %1, off\n\ts_mov_b32 m0, %0" : "=&s"(keep) : "v"(gsrc), "s"(lds_dst) : "memory"); }
typedef short v4i16_t __attribute__((ext_vector_type(4)));
typedef LAS const char* lds_cptr;
__device__ __forceinline__ s16x4 vtr(lds_cptr p) { return __builtin_bit_cast(s16x4, __builtin_amdgcn_ds_read_tr16_b64_v4i16((LAS v4i16_t*)p)); }

__device__ __forceinline__ void attn_unit(int b, int h, int qb, const bf16_t* Q, const bf16_t* __restrict__ Kt, const bf16_t* __restrict__ Vt, bf16_t* O, char* shm) {
    int tid = threadIdx.x; asm volatile("" : "+v"(tid));
    const int lane = tid & 63, r32 = lane & 31, hi = lane >> 5; const int wid = __builtin_amdgcn_readfirstlane(tid >> 6);
    const int q0 = qb * 256; const int NT = 4 * (qb + 1);
    const size_t rowbase = (size_t)b * SEQ;
    const bf16_t* Kbh = Kt + (size_t)(b * NH + h) * 32 * 6144;
    const bf16_t* Vbh = Vt + (size_t)(b * NH + h) * 32 * 4096;
    const unsigned lds0 = (unsigned)(uintptr_t)shm;
    const lds_cptr shm3 = (lds_cptr)shm;
    LAS float* wsf = (LAS float*)(shm3 + WSF_OFF) + wid * 64;
#define ATT_DMA(t, sl) do { const bf16_t* kt_ = Kbh + (size_t)(t) * 6144; const bf16_t* vt_ = Vbh + (size_t)(t) * 4096; const unsigned sb_ = lds0 + (sl) * SLOT; \
        glds16(kt_ + wid * 512 + lane * 8, (unsigned)__builtin_amdgcn_readfirstlane(sb_ + wid * 1024)); \
        if (wid < 4) { glds16(kt_ + (wid + 8) * 512 + lane * 8, (unsigned)__builtin_amdgcn_readfirstlane(sb_ + (wid + 8) * 1024)); \
                       glds16(vt_ + (wid + 4) * 512 + lane * 8, (unsigned)__builtin_amdgcn_readfirstlane(sb_ + KSLOT + (wid + 4) * 1024)); } \
        else { glds16(vt_ + (wid - 4) * 512 + lane * 8, (unsigned)__builtin_amdgcn_readfirstlane(sb_ + KSLOT + (wid - 4) * 1024)); } } while (0)
    ATT_DMA(0, 0); ATT_DMA(1, 1);
    bf16x8 qr[6];
    { const bf16_t* Qw = Q + (rowbase + q0 + wid * 32 + r32) * (size_t)(NH * DQK) + h * DQK + hi * 8;
#pragma unroll
      for (int d0 = 0; d0 < 6; ++d0) qr[d0] = *(const bf16x8*)(Qw + d0 * 16); }
    constexpr float SUM_THR = ATT_SUM_THR;
    float mhat = 0.f, l_reg = 0.f; f32x16 o[2]; o[0] = f32x16{}; o[1] = f32x16{}; f32x16 negm = f32x16{};
    const int qrel = wid * 32 + r32;
    const int vpo = ((lane >> 4) & 1) * 32 + (lane & 3) * 8 + (4 * hi + ((lane & 15) >> 2)) * 64;
    asm volatile("s_waitcnt vmcnt(0)" ::: "memory");
    const int grp = wid >> 2;
    u32x4 pw[4]; bool pend = false;
    int sl = 0, slp = 0;
#define ATT_PV(PW, slot) do { const lds_cptr vp_ = shm3 + (slot) * SLOT + KSLOT + vpo; \
        _Pragma("unroll") for (int d0 = 0; d0 < 2; ++d0) _Pragma("unroll") for (int ks = 0; ks < 4; ks += 2) { \
            const s16x4 lo = vtr(vp_ + d0 * 4096 + ks * 1024), hh = vtr(vp_ + d0 * 4096 + ks * 1024 + 512); \
            const s16x4 lo2 = vtr(vp_ + d0 * 4096 + (ks + 1) * 1024), hh2 = vtr(vp_ + d0 * 4096 + (ks + 1) * 1024 + 512); \
            __builtin_amdgcn_sched_barrier(0); \
            const bf16x8 vf = (bf16x8){lo[0], lo[1], lo[2], lo[3], hh[0], hh[1], hh[2], hh[3]}, vf2 = (bf16x8){lo2[0], lo2[1], lo2[2], lo2[3], hh2[0], hh2[1], hh2[2], hh2[3]}; \
            o[d0] = __builtin_amdgcn_mfma_f32_32x32x16_bf16(__builtin_bit_cast(bf16x8, PW[ks]), vf, o[d0], 0, 0, 0); \
            o[d0] = __builtin_amdgcn_mfma_f32_32x32x16_bf16(__builtin_bit_cast(bf16x8, PW[ks + 1]), vf2, o[d0], 0, 0, 0); } } while (0)
    for (int t = 0; t < NT; ++t) {
        if (t > 0) { if (t + 1 < NT) { if (wid < 4) asm volatile("s_waitcnt vmcnt(3)" ::: "memory"); else asm volatile("s_waitcnt vmcnt(2)" ::: "memory"); } else asm volatile("s_waitcnt vmcnt(0)" ::: "memory"); }
        asm volatile("s_waitcnt lgkmcnt(0)\n\ts_barrier" ::: "memory");
        if (t + 2 < NT) { const int s2 = (sl + 2) & 3; ATT_DMA(t + 2, s2); }
        const int slc = sl; sl = (sl + 1) & 3;
        const lds_cptr kp = shm3 + slc * SLOT + hi * 1024 + r32 * 16;
#define ATT_KLD(G_, d0_) const bf16x8 G_##0 = *(const LAS bf16x8*)(kp + (d0_) * 2048), G_##1 = *(const LAS bf16x8*)(kp + (d0_) * 2048 + 512), \
                                      G_##2 = *(const LAS bf16x8*)(kp + ((d0_) + 1) * 2048), G_##3 = *(const LAS bf16x8*)(kp + ((d0_) + 1) * 2048 + 512)
#define ATT_KMM(G_, d0_) do { p0 = __builtin_amdgcn_mfma_f32_32x32x16_bf16(G_##0, qr[d0_], p0, 0, 0, 0); p1 = __builtin_amdgcn_mfma_f32_32x32x16_bf16(G_##1, qr[d0_], p1, 0, 0, 0); \
                              p0 = __builtin_amdgcn_mfma_f32_32x32x16_bf16(G_##2, qr[(d0_) + 1], p0, 0, 0, 0); p1 = __builtin_amdgcn_mfma_f32_32x32x16_bf16(G_##3, qr[(d0_) + 1], p1, 0, 0, 0); } while (0)
        ATT_KLD(ka, 0);
        __builtin_amdgcn_sched_barrier(0);
        if (grp && pend) { ATT_PV(pw, slp); pend = false; }
        slp = slc;
        const int jb = t - (NT - 4);
        if (jb >= 0 && 64 * jb > 32 * wid + 31) continue;
        f32x16 p0 = negm, p1 = negm;
        {
            ATT_KLD(kb, 2);
            __builtin_amdgcn_sched_barrier(0);
            ATT_KMM(ka, 0);
            __builtin_amdgcn_sched_barrier(0);
            ATT_KLD(kc, 4);
            __builtin_amdgcn_sched_barrier(0);
            ATT_KMM(kb, 2);
            __builtin_amdgcn_sched_barrier(0);
            ATT_KMM(kc, 4);
#undef ATT_KLD
#undef ATT_KMM
        }
        if (jb >= 0 && 64 * jb + 63 > 32 * wid) { const int kb = 64 * jb + 4 * hi;
#pragma unroll
            for (int r = 0; r < 16; ++r) { const int kv = kb + (r & 3) + 8 * (r >> 2); if (kv > qrel) p0[r] = -INFINITY; if (kv + 32 > qrel) p1[r] = -INFINITY; } }
        f32x2 sa2 = {0.f, 0.f}, sb2 = {0.f, 0.f};
#pragma unroll
        for (int r = 0; r < 16; r += 2) { p0[r] = fexp2(p0[r]); p0[r + 1] = fexp2(p0[r + 1]); p1[r] = fexp2(p1[r]); p1[r + 1] = fexp2(p1[r + 1]);
            sa2 += (f32x2){p0[r], p0[r + 1]}; sb2 += (f32x2){p1[r], p1[r + 1]}; }
        sa2 += sb2; float sacc = sa2.x + sa2.y;
        if (__any(sacc > SUM_THR)) {
            const float s2 = xmax32(sacc);
            const float dl = s2 > SUM_THR ? floorf(__builtin_amdgcn_logf(s2)) : 0.f; mhat += dl;
            const float f = fexp2(-dl); l_reg *= f; sacc *= f;
#pragma unroll
            for (int r = 0; r < 16; ++r) { p0[r] *= f; p1[r] *= f; negm[r] = -mhat; }
            if (hi == 0) wsf[r32] = f;
            LDS_WAIT();
#pragma unroll
            for (int j = 0; j < 4; ++j) { const f32x4 fv = *(const LAS f32x4*)(wsf + 8 * j + 4 * hi);
#pragma unroll
                for (int i = 0; i < 4; ++i) { o[0][4 * j + i] *= fv[i]; o[1][4 * j + i] *= fv[i]; } }
        }
        l_reg += sacc;
#pragma unroll
        for (int k = 0; k < 2; ++k) {
            pw[k] = (u32x4){cvt_pk_bf16(p0[8 * k], p0[8 * k + 1]), cvt_pk_bf16(p0[8 * k + 2], p0[8 * k + 3]), cvt_pk_bf16(p0[8 * k + 4], p0[8 * k + 5]), cvt_pk_bf16(p0[8 * k + 6], p0[8 * k + 7])};
            pw[2 + k] = (u32x4){cvt_pk_bf16(p1[8 * k], p1[8 * k + 1]), cvt_pk_bf16(p1[8 * k + 2], p1[8 * k + 3]), cvt_pk_bf16(p1[8 * k + 4], p1[8 * k + 5]), cvt_pk_bf16(p1[8 * k + 6], p1[8 * k + 7])};
        }
        if (grp) pend = true; else ATT_PV(pw, slc);
    }
    if (grp && pend) ATT_PV(pw, slp);
#undef ATT_PV
    l_reg = xsum32(l_reg);
    if (hi == 0) wsf[32 + r32] = l_reg;
    LDS_WAIT();
    float rli[16];
#pragma unroll
    for (int j = 0; j < 4; ++j) { const f32x4 f = *(const LAS f32x4*)(wsf + 32 + 8 * j + 4 * hi);
#pragma unroll
        for (int i = 0; i < 4; ++i) rli[4 * j + i] = frcp(f[i]); }
    { LAS bf16_t* stg = (LAS bf16_t*)(shm3 + OST_OFF) + wid * 2048;
#pragma unroll
      for (int r = 0; r < 16; ++r) { const int orow = crow(r, hi);
#pragma unroll
          for (int d0 = 0; d0 < 2; ++d0) stg[orow * 64 + d0 * 32 + r32] = (bf16_t)(cvt_pk_bf16(o[d0][r] * rli[r], 0.f) & 0xffffu); }
      LDS_WAIT();
      bf16_t* Ow = O + (rowbase + q0 + wid * 32) * (size_t)AOO_LD + h * DV;
#pragma unroll
      for (int i = 0; i < 4; ++i) { const int row = i * 8 + (lane >> 3), ch = lane & 7; const u32x4 v = *(const LAS u32x4*)(stg + row * 64 + ch * 8); *(u32x4*)(Ow + (size_t)row * AOO_LD + ch * 8) = v; } }
    asm volatile("s_waitcnt lgkmcnt(0)\n\ts_barrier" ::: "memory");
#undef ATT_DMA
}
}

__device__ __forceinline__ void gmlp_phase(int first, int stride, int nunits, const bf16_t* U, const bf16_t* Vg, const float* vstp, const float* vng, const float* vnb,
                                           const float* wsp, const float* bsp, bf16_t* AO, LAS unsigned char* lds) {
    int tid = threadIdx.x; asm volatile("" : "+v"(tid));
    const int lane = tid & 63, r32 = lane & 31, hi = lane >> 5; const int wid = __builtin_amdgcn_readfirstlane(tid >> 6);
    LAS bf16_t* vnT = (LAS bf16_t*)lds;
    LAS float* st = (LAS float*)(lds + 34816);
    LAS float* MX = (LAS float*)(lds + 36864);
    const int tb = wid >> 1, dh = wid & 1, nk = 2 * (tb + 1);
    const int trow = 32 * tb + r32, dch0 = tid & 15;
#define GM_LOAD(L_, SP, VG, UU) do { const size_t r0_ = (size_t)((L_) >> 7) * SEQ + (size_t)(((L_) >> 3) & 15) * 128; const int g_ = (L_) & 7; \
        if (tid < 128) { const float* p_ = vstp + (r0_ + tid) * 32; _Pragma("unroll") for (int j = 0; j < 8; ++j) SP[j] = *(const f32x4*)(p_ + 4 * j); } \
        _Pragma("unroll") for (int j = 0; j < 4; ++j) { const int q_ = tid + 512 * j, s_ = q_ >> 4; const size_t o_ = (r0_ + s_) * D + 128 * g_ + 8 * dch0; \
            VG[j] = ld_nt(Vg + o_); UU[j] = ld_nt(U + o_); } } while (0)
    int L = first; if (L >= nunits) return;
    f32x4 spA[8]; u32x4 vgA[4], uuA[4];
    GM_LOAD(L, spA, vgA, uuA);
    int gcur = -1; bf16x8 wa[8]; f32x4 bs4[4], g0, g1, b0, b1;
    while (L < nunits) {
        const int Ln = L + stride;
        f32x4 spB[8]; u32x4 vgB[4], uuB[4];
        const int g = L & 7; const size_t r0 = (size_t)(L >> 7) * SEQ + (size_t)((L >> 3) & 15) * 128;
        if (g != gcur) { gcur = g;
            const float* wrow = wsp + ((size_t)g * 128 + trow) * 128 + 8 * hi;
#pragma unroll
            for (int kk = 0; kk < 8; ++kk) if (kk < nk) { f32x4 w0 = *(const f32x4*)(wrow + 16 * kk), w1 = *(const f32x4*)(wrow + 16 * kk + 4); const int s0 = 16 * kk + 8 * hi;
#pragma unroll
                for (int e = 0; e < 4; ++e) { if (s0 + e > trow) w0[e] = 0.f; if (s0 + 4 + e > trow) w1[e] = 0.f; }
                wa[kk] = __builtin_bit_cast(bf16x8, pack8(w0, w1)); }
#pragma unroll
            for (int j = 0; j < 4; ++j) bs4[j] = *(const f32x4*)(bsp + g * 128 + 32 * tb + 8 * j + 4 * hi);
            g0 = *(const f32x4*)(vng + 128 * g + 8 * dch0); g1 = *(const f32x4*)(vng + 128 * g + 8 * dch0 + 4);
            b0 = *(const f32x4*)(vnb + 128 * g + 8 * dch0); b1 = *(const f32x4*)(vnb + 128 * g + 8 * dch0 + 4); }
        if (tid < 128) { float s1 = 0.f, s2 = 0.f;
#pragma unroll
            for (int j = 0; j < 8; ++j) { s1 += spA[j].x + spA[j].z; s2 += spA[j].y + spA[j].w; }
            const float mean = s1 * (1.0f / D); const float var = s2 * (1.0f / D) - mean * mean;
            st[tid] = mean; st[128 + tid] = frsq(var + EPS); }
        LDS_WAIT(); RAW_BAR();
#pragma unroll
        for (int j = 0; j < 4; ++j) { const int q = tid + 512 * j, s_ = q >> 4;
            const float mean = st[s_], rstd = st[128 + s_]; const u32x4 w = vgA[j];
            float v[8] = {bf_lo(w.x), bf_hi(w.x), bf_lo(w.y), bf_hi(w.y), bf_lo(w.z), bf_hi(w.z), bf_lo(w.w), bf_hi(w.w)};
#pragma unroll
            for (int e = 0; e < 8; ++e) { const float gg = e < 4 ? g0[e] : g1[e - 4], bb = e < 4 ? b0[e] : b1[e - 4];
                vnT[(8 * dch0 + e) * 136 + (s_ ^ (8 * dch0))] = (bf16_t)(cvt_pk_bf16((v[e] - mean) * rstd * gg + bb, 0.f) & 0xffffu); } }
        if (Ln < nunits) GM_LOAD(Ln, spB, vgB, uuB);
        LDS_WAIT(); RAW_BAR();
        f32x16 acc[2]; acc[0] = f32x16{}; acc[1] = f32x16{};
#pragma unroll
        for (int kk = 0; kk < 8; kk += 2) if (kk < nk) {
            bf16x8 bfr[2][2];
#pragma unroll
            for (int k2 = 0; k2 < 2; ++k2) { const int s0 = 16 * (kk + k2) + 8 * hi;
#pragma unroll
                for (int db = 0; db < 2; ++db) bfr[k2][db] = *(const LAS bf16x8*)(vnT + (64 * dh + 32 * db + r32) * 136 + (s0 ^ (8 * (8 * dh + 4 * db + (r32 >> 3))))); }
            __builtin_amdgcn_sched_barrier(0);
#pragma unroll
            for (int k2 = 0; k2 < 2; ++k2)
#pragma unroll
                for (int db = 0; db < 2; ++db) acc[db] = __builtin_amdgcn_mfma_f32_32x32x16_bf16(wa[kk + k2], bfr[k2][db], acc[db], 0, 0, 0);
        }
#pragma unroll
        for (int r = 0; r < 16; ++r) { const int t = 32 * tb + crow(r, hi); const float bs = bs4[r >> 2][r & 3];
#pragma unroll
            for (int db = 0; db < 2; ++db) MX[t * 132 + 64 * dh + 32 * db + r32] = acc[db][r] + bs; }
        LDS_WAIT(); RAW_BAR();
#pragma unroll
        for (int j = 0; j < 4; ++j) { const int q = tid + 512 * j, s_ = q >> 4;
            const f32x4 m0 = *(const LAS f32x4*)(MX + s_ * 132 + 8 * dch0), m1 = *(const LAS f32x4*)(MX + s_ * 132 + 8 * dch0 + 4); const u32x4 w = uuA[j];
            const f32x4 ua = {bf_lo(w.x), bf_hi(w.x), bf_lo(w.y), bf_hi(w.y)}, ub = {bf_lo(w.z), bf_hi(w.z), bf_lo(w.w), bf_hi(w.w)};
            *(u32x4*)(AO + (r0 + s_) * AOO_LD + 128 * g + 8 * dch0) = pack8(ua * m0, ub * m1); }
#pragma unroll
        for (int j = 0; j < 8; ++j) spA[j] = spB[j];
#pragma unroll
        for (int j = 0; j < 4; ++j) { vgA[j] = vgB[j]; uuA[j] = uuB[j]; }
        L = Ln;
    }
#undef GM_LOAD
    LDS_WAIT(); RAW_BAR();
}

typedef const __attribute__((address_space(4))) unsigned char* kargp_t;
__device__ __forceinline__ kargp_t kargp() { kargp_t k = (kargp_t)__builtin_amdgcn_kernarg_segment_ptr(); asm volatile("" : "+s"(k)); return k; }
#define KARG(off, T) (*(T const __attribute__((address_space(4)))*)(kargp() + (off)))
#define INP(i) KARG(8 * (i), const float*)
#define OUTP() KARG(184, float*)
#define WSP() KARG(192, unsigned char*)

struct MapNat { __device__ __forceinline__ int operator()(int j4) const { return j4; } };
struct MapW1 { __device__ __forceinline__ int operator()(int j4) const { const int j = 4 * j4;
    if (j < 2816) return j4;
    if (j >= 3072) { const int q = j - 3072, p = q & 255; return (2848 + (q & ~255) + 64 * ((p >> 5) & 3) + 16 * ((p >> 3) & 3) + 8 * (p >> 7) + (p & 7)) >> 2; } const int p = j - 2816; if (p >= 32) return -1; return (2816 + 16 * ((p >> 2) & 1) + 4 * (p >> 3)) >> 2; } };
struct MapUQ { __device__ __forceinline__ int operator()(int j4) const { const int j = 4 * j4, t = j >> 8, p = j & 255, bj = p >> 7, wc = (p >> 5) & 3, q = p & 31; const int head = 2 * t + (wc >> 1);
    int dim; if (bj == 0) dim = 32 * (wc & 1) + q; else { if (wc & 1) return -1; dim = 64 + 16 * ((q >> 2) & 1) + 4 * (q >> 3); } return (head * DQK + dim) >> 2; } };
struct MapUKV { __device__ __forceinline__ int operator()(int j4) const { const int j = 4 * j4, t = j >> 8, p = j & 255, bj = p >> 7, wc = (p >> 5) & 3, q = p & 31;
    return ((2 * t + (wc >> 1)) * 128 + (wc & 1) * 64 + 32 * bj + q) >> 2; } };
struct MapGU { __device__ __forceinline__ int operator()(int j4) const { const int j = 4 * j4, t = j >> 8, bj = (j >> 7) & 1, q = j & 127; return (bj * FF + 128 * t + q) >> 2; } };

struct TrDesc { const float* W; bf16_t* WT; const float* scale; float mul; int K, Nsrc, mtype, item, ldw, esz; };
__device__ __forceinline__ int tr_map(int mtype, int j4) {
    switch (mtype) { case 1: return MapW1()(j4); case 2: return MapUQ()(j4); case 3: return MapUKV()(j4); case 4: return MapGU()(j4); default: return j4; } }
__device__ __forceinline__ void tr_load(const TrDesc& d, f32x4 (&v)[16], int lane) {
    const int nblk_k = d.K >> 6; const int nb = d.item / nblk_k, kb = d.item - nb * nblk_k; const int k0 = kb * 64, n0 = nb * 64;
    const int g4 = lane & 15, c = lane >> 4;
    const int src4 = tr_map(d.mtype, (n0 >> 2) + g4);
#pragma unroll
    for (int p = 0; p < 2; ++p) { const int kk = k0 + 32 * p + 8 * c;
        f32x4 sc0 = {1.f, 1.f, 1.f, 1.f}, sc1 = sc0; if (d.scale) { sc0 = *(const f32x4*)(d.scale + kk); sc1 = *(const f32x4*)(d.scale + kk + 4); }
#pragma unroll
        for (int i = 0; i < 8; ++i) { const float sc = i < 4 ? sc0[i] : sc1[i - 4];
            if (src4 >= 0) v[8 * p + i] = __builtin_nontemporal_load((const f32x4*)(d.W + (size_t)(kk + i) * d.Nsrc + 4 * src4)) * (sc * d.mul); else v[8 * p + i] = (f32x4){0.f, 0.f, 0.f, 0.f}; } }
}
__device__ __forceinline__ void tr_store(const TrDesc& d, const f32x4 (&v)[16], LAS float*, int lane) {
    const int nblk_k = d.K >> 6; const int nb = d.item / nblk_k, kb = d.item - nb * nblk_k; const int k0 = kb * 64, n0 = nb * 64;
    const int g4 = lane & 15, c = lane >> 4;
    if (d.esz == 1) {
#pragma unroll
        for (int j = 0; j < 4; ++j) {
            const u32x2 c0 = pack8_f8((f32x4){v[0][j], v[1][j], v[2][j], v[3][j]}, (f32x4){v[4][j], v[5][j], v[6][j], v[7][j]});
            const u32x2 c1 = pack8_f8((f32x4){v[8][j], v[9][j], v[10][j], v[11][j]}, (f32x4){v[12][j], v[13][j], v[14][j], v[15][j]});
            const auto t0 = __builtin_amdgcn_permlane32_swap(c0.x, c1.x, false, false), t1 = __builtin_amdgcn_permlane32_swap(c0.y, c1.y, false, false);
            const auto u0 = __builtin_amdgcn_permlane16_swap(t0[0], t0[1], false, false), u1 = __builtin_amdgcn_permlane16_swap(t1[0], t1[1], false, false);
            *(u32x4*)((unsigned char*)d.WT + (size_t)(n0 + 4 * g4 + j) * d.ldw + k0 + 16 * c) = (u32x4){u0[0], u1[0], u0[1], u1[1]}; }
        return; }
#pragma unroll
    for (int p = 0; p < 2; ++p)
#pragma unroll
        for (int j = 0; j < 4; ++j) {
            { u32x4 o;
            o.x = cvt_pk_bf16(v[8 * p + 0][j], v[8 * p + 1][j]); o.y = cvt_pk_bf16(v[8 * p + 2][j], v[8 * p + 3][j]); o.z = cvt_pk_bf16(v[8 * p + 4][j], v[8 * p + 5][j]); o.w = cvt_pk_bf16(v[8 * p + 6][j], v[8 * p + 7][j]);
            *(u32x4*)(d.WT + (size_t)(n0 + 4 * g4 + j) * d.ldw + k0 + 32 * p + 8 * c) = o; } }
}
constexpr int TR_LAYER = 2432, TR_DENSE = 2112, TR_EXP = 2112, TR_TOTAL = 2 * TR_LAYER + TR_DENSE + 8 * TR_EXP;
__device__ __forceinline__ TrDesc tr_decode(int it, unsigned char* ws) {
    TrDesc d; d.scale = nullptr; d.mtype = 0; d.mul = 1.0f; d.esz = 2;
    if (it < 2 * TR_LAYER) { const int l = it / TR_LAYER; int r = it - l * TR_LAYER; unsigned char* wl = ws + WS_WL + l * WL_STRIDE;
        if (r < 1280) { d.ldw = D; d.W = INP(2) + (size_t)l * D * DIN; d.K = D; d.Nsrc = DIN; d.WT = (bf16_t*)(wl + WL_W1T); d.scale = INP(1) + l * D; d.mtype = 1; d.item = r; return d; } r -= 1280;
        if (r < 256) { d.ldw = QL; d.W = INP(9) + (size_t)l * QL * (NH * DQK); d.K = QL; d.Nsrc = NH * DQK; d.WT = (bf16_t*)(wl + WL_WUQ); d.scale = INP(8) + l * QL; d.mtype = 2; d.item = r; return d; } r -= 256;
        if (r < 128) { d.ldw = KVL; d.W = INP(11) + (size_t)l * KVL * (NH * 128); d.K = KVL; d.Nsrc = NH * 128; d.WT = (bf16_t*)(wl + WL_WUKV); d.scale = INP(10) + l * KVL; d.mtype = 3; d.item = r; return d; } r -= 128;
        const int w = r >> 8; d.item = r & 255; d.K = D; d.Nsrc = D;
        d.W = (w == 0 ? INP(7) : w == 1 ? INP(14) : INP(15)) + (size_t)l * D * D; d.ldw = (w == 2) ? D : 2 * D;
        d.WT = (w == 2) ? (bf16_t*)(wl + WL_WOUT) : (bf16_t*)(wl + WL_PA) + w * D; return d; }
    it -= 2 * TR_LAYER;
    if (it < TR_DENSE) {
        if (it < 1408) { d.ldw = D; d.W = INP(17); d.K = D; d.Nsrc = 2 * FF; d.WT = (bf16_t*)(ws + WS_WGU); d.scale = INP(16); d.mtype = 4; d.item = it; return d; }
        d.ldw = FF; d.W = INP(18); d.K = FF; d.Nsrc = D; d.WT = (bf16_t*)(ws + WS_WD); d.item = it - 1408; return d; }
    it -= TR_DENSE;
    const int e = it / TR_EXP; const int r = it - e * TR_EXP;
    if (r < 1408) { d.ldw = D; d.W = INP(21) + (size_t)e * D * 2 * FF; d.K = D; d.Nsrc = 2 * FF; d.WT = (bf16_t*)(ws + WS_MGU + (size_t)e * 2 * FF * D * MESZ); d.scale = INP(16) + D; d.mtype = 4; d.item = r; d.mul = W8_SCALE; d.esz = MESZ; return d; }
    d.ldw = FF; d.W = INP(22) + (size_t)e * FF * D; d.K = FF; d.Nsrc = D; d.WT = (bf16_t*)(ws + WS_MD + (size_t)e * D * FF * MESZ); d.item = r - 1408; d.mul = W8_SCALE; d.esz = MESZ; return d;
}


#ifndef DBG_STOP
#define DBG_STOP (-1)
#endif
__device__ __forceinline__ void dump_bf16(float* out, const bf16_t* src, size_t n, bool first) {
    const size_t gt = (size_t)blockIdx.x * 512 + threadIdx.x, gs = (size_t)gridDim.x * 512;
    for (size_t i = gt; i < (size_t)M * D; i += gs) { float a = first ? 0.f : out[i]; for (size_t j = i; j < n; j += (size_t)M * D) a += bf1(src[j]); out[i] = a; } }
__device__ __forceinline__ void dump_f32(float* out, const float* src, size_t n, bool first) {
    const size_t gt = (size_t)blockIdx.x * 512 + threadIdx.x, gs = (size_t)gridDim.x * 512;
    for (size_t i = gt; i < (size_t)M * D; i += gs) { float a = first ? 0.f : out[i]; for (size_t j = i; j < n; j += (size_t)M * D) a += src[j]; out[i] = a; } }
#define DBG_AT(id, ...) do { if (DBG_STOP == (id)) { GRID_BAR(); unsigned char* ws = WSP(); float* out = OUTP(); (void)ws; __VA_ARGS__; return; } } while (0)
struct Params { const float* in[23]; float* out; unsigned char* ws; int mode, pad; };
static_assert(sizeof(Params) == 208, "kernarg layout");
#ifndef DBG_TWO
#define DBG_TWO 0
#endif
#ifndef REP_MASK
#define REP_MASK 0
#endif
#define REP(id) for (int rep_ = 0; rep_ < (((REP_MASK) >> (id)) & 1) + 1; ++rep_)

__global__ void __launch_bounds__(512, 2) fwd_kernel(Params p) {
    extern __shared__ __attribute__((aligned(16))) unsigned char lds_raw[];
    LAS unsigned char* lds = (LAS unsigned char*)lds_raw;
    { const int tid = threadIdx.x; volatile LAS unsigned* MISC = (volatile LAS unsigned*)(lds + MISC_OFF);
      for (int u = tid; u < 64; u += 512) MISC[u] = 0u;
      __syncthreads();
      (void)xcd_barrier_post((unsigned*)(WSP() + WS_CTL) + CW_BAR, MISC + 8); }
#ifndef BAR_REP
#define BAR_REP 1
#endif
#define GRID_BAR() for (int br_ = 0; br_ < BAR_REP; ++br_) do { XcdBarrier b_; b_.bar = (unsigned*)(WSP() + WS_CTL) + CW_BAR; b_.x = xb_xcc_id(); b_.st = (volatile LAS unsigned*)(lds + MISC_OFF) + 8; xcd_barrier(b_); } while (0)
#define GRID_G ((int)gridDim.x)
#define GRID_BX ((int)blockIdx.x)
#define VCU ((GRID_G % 8 == 0) ? (GRID_BX % 8) * (GRID_G / 8) + GRID_BX / 8 : GRID_BX)

    REP(0) if (!DBG_TWO || KARG(200, int) != 2) {
        unsigned char* ws = WSP();
        int tid = threadIdx.x; asm volatile("" : "+v"(tid)); const int lane = tid & 63, wave = __builtin_amdgcn_readfirstlane(tid >> 6);
        const int G = GRID_G, bx = GRID_BX; const int gw = VCU * 8 + wave, NGW = G * 8;
        LAS float* scr = (LAS float*)(lds + wave * 16640);
        {
            f32x4 va[16], vb[16], vc[16]; int it = gw;
            TrDesc da = tr_decode(TR_TOTAL - 1 - it, ws), db = da, dc = da;
            tr_load(da, va, lane);
            if (it + NGW < TR_TOTAL) { db = tr_decode(TR_TOTAL - 1 - (it + NGW), ws); tr_load(db, vb, lane); }
            while (it < TR_TOTAL) {
                if (it + 2 * NGW < TR_TOTAL) { dc = tr_decode(TR_TOTAL - 1 - (it + 2 * NGW), ws); tr_load(dc, vc, lane); }
                tr_store(da, va, scr, lane); it += NGW; if (it >= TR_TOTAL) break;
                if (it + 2 * NGW < TR_TOTAL) { da = tr_decode(TR_TOTAL - 1 - (it + 2 * NGW), ws); tr_load(da, va, lane); }
                tr_store(db, vb, scr, lane); it += NGW; if (it >= TR_TOTAL) break;
                if (it + 2 * NGW < TR_TOTAL) { db = tr_decode(TR_TOTAL - 1 - (it + 2 * NGW), ws); tr_load(db, vb, lane); }
                tr_store(dc, vc, scr, lane); it += NGW;
            }
        }
        { const float* x = INP(0); bf16_t* XB = (bf16_t*)(ws + WS_XB); float* xssp = (float*)(ws + WS_XSSP);
          for (int m0 = gw; m0 < M; m0 += 4 * NGW) {
            f32x4 v[4][4];
#pragma unroll
            for (int q = 0; q < 4; ++q) { const int m = m0 + q * NGW; if (m < M) { const f32x4* xr = (const f32x4*)(x + (size_t)m * D) + lane;
#pragma unroll
                for (int j = 0; j < 4; ++j) v[q][j] = __builtin_nontemporal_load(xr + 64 * j); } }
            __builtin_amdgcn_sched_barrier(0);
#pragma unroll
            for (int q = 0; q < 4; ++q) { const int m = m0 + q * NGW; if (m < M) { float s = 0.f; u32x2* o8 = (u32x2*)(XB + (size_t)m * D) + lane;
#pragma unroll
                for (int j = 0; j < 4; ++j) { s += sum4(v[q][j] * v[q][j]); o8[64 * j] = (u32x2){cvt_pk_bf16(v[q][j].x, v[q][j].y), cvt_pk_bf16(v[q][j].z, v[q][j].w)}; }
                s = wave_sum(s);
                if (lane == 0) *(f32x4*)(xssp + (size_t)m * 4) = (f32x4){s, 0.f, 0.f, 0.f}; } }
          } }
        for (int i = bx * 512 + tid; i < SEQ * 16; i += G * 512) { const int pos = i >> 4, j = i & 15;
            const float inv = powf(10000.0f, -(float)(2 * j) / 32.0f); const float ang = (float)pos * inv;
            ((float*)(ws + WS_ROPE))[i] = cosf(ang); ((float*)(ws + WS_ROPE))[SEQ * 16 + i] = sinf(ang); }
    }
    if (DBG_TWO && KARG(200, int) == 1) return;
    GRID_BAR();
    DBG_AT(0, dump_bf16(out, (const bf16_t*)(ws + WS_XB), (size_t)M * D, true); dump_f32(out, (const float*)(ws + WS_ROPE), (size_t)SEQ * 32 + (size_t)M * 4, false); dump_bf16(out, (const bf16_t*)(ws + WS_WL), (WS_WD + (size_t)D * FF * 2 - WS_WL) / 2, false); dump_bf16(out, (const bf16_t*)(ws + WS_MGU), (WS_XB - WS_MGU) / 2, false));

#pragma unroll 1
    for (int l = 0; l < 2; ++l) {
        REP(1) {
            unsigned char* ws = WSP(); unsigned char* wl = ws + WS_WL + l * WL_STRIDE;
            const float* cosT = (const float*)(ws + WS_ROPE); const float* sinT = cosT + SEQ * 16;
            SchedStd S; S.init(M / 256, N1 / 256, GRID_G, GRID_BX); S.A = (const char*)(ws + WS_XB); S.Bt = (const char*)(wl + WL_W1T); S.astep = 256 * (size_t)D * 2; S.bstep = 256 * (size_t)D * 2;
            EpiG1 E{(const float*)(ws + WS_XSSP), (bf16_t*)(ws + WS_U), (bf16_t*)(ws + WS_VG), (bf16_t*)(ws + WS_CQ), (bf16_t*)(ws + WS_CKV), (bf16_t*)(ws + WS_G),
                    (float*)(ws + WS_VSTP), (float*)(ws + WS_CQP), (float*)(ws + WS_CKVP), (float*)(ws + WS_KR), (float*)(ws + WS_KRSS), INP(13) + l * DQK, cosT, sinT};
#if DBG_STOP == 21
            EpiRaw ER{(bf16_t*)(ws + WS_U), N1};
            pg8::gemm_phase<EpiRaw, SchedStd, true, false>(lds, D, D, D, S, ER);
#else
            pg8::gemm_phase<EpiG1, SchedStd, true, false>(lds, D, D, D, S, E);
#endif
        }
        GRID_BAR();
        DBG_AT(21, dump_bf16(out, (const bf16_t*)(ws + WS_U), (size_t)M * N1, true));
        if (DBG_STOP == 10 * l + 1) DBG_AT(10 * l + 1, dump_bf16(out, (const bf16_t*)(ws + WS_U), (size_t)M * 4096, true); dump_bf16(out, (const bf16_t*)(ws + WS_CQ), (size_t)M * 768, false); dump_f32(out, (const float*)(ws + WS_VSTP), (size_t)M * 32, false); dump_f32(out, (const float*)(ws + WS_CQP), (size_t)M * 8, false); dump_f32(out, (const float*)(ws + WS_CKVP), (size_t)M * 4, false); dump_f32(out, (const float*)(ws + WS_KRSS), (size_t)M, false); dump_f32(out, (const float*)(ws + WS_KR), (size_t)M * 32, false));
        REP(2) {
            unsigned char* ws = WSP(); unsigned char* wl = ws + WS_WL + l * WL_STRIDE;
            const float* cosT = (const float*)(ws + WS_ROPE); const float* sinT = cosT + SEQ * 16;
            SchedStd S; S.init(M / 256, NQ / 256, GRID_G, GRID_BX); S.A = (const char*)(ws + WS_CQ); S.Bt = (const char*)(wl + WL_WUQ); S.astep = 256 * (size_t)QL * 2; S.bstep = 256 * (size_t)QL * 2;
            EpiQ E{(const float*)(ws + WS_CQP), INP(12) + l * DQK, cosT, sinT, (bf16_t*)(ws + WS_Q)};
            pg8::gemm_phase<EpiQ, SchedStd, true, false>(lds, QL, QL, QL, S, E);
        }
        REP(3) {
            unsigned char* ws = WSP(); unsigned char* wl = ws + WS_WL + l * WL_STRIDE;
            SchedStd S; S.init(M / 256, NKV / 256, GRID_G, GRID_BX); S.A = (const char*)(ws + WS_CKV); S.Bt = (const char*)(wl + WL_WUKV); S.astep = 256 * (size_t)KVL * 2; S.bstep = 256 * (size_t)KVL * 2;
            EpiKV E{(const float*)(ws + WS_CKVP), (const float*)(ws + WS_KRSS), (const float*)(ws + WS_KR), INP(13) + l * DQK, (bf16_t*)(ws + WS_KT), (bf16_t*)(ws + WS_VT)};
            pg8::gemm_phase<EpiKV, SchedStd, true, false>(lds, KVL, KVL, KVL, S, E);
        }
        REP(4) {
            unsigned char* ws = WSP();
            gmlp_phase(VCU, GRID_G, NBATCH * 16 * 8, (const bf16_t*)(ws + WS_U), (const bf16_t*)(ws + WS_VG), (const float*)(ws + WS_VSTP), INP(3) + l * D, INP(4) + l * D,
                       INP(5) + (size_t)l * 8 * 128 * 128, INP(6) + l * 8 * 128, (bf16_t*)(ws + WS_AO), lds);
        }
        GRID_BAR();
        if (DBG_STOP == 10 * l + 2) DBG_AT(10 * l + 2, dump_bf16(out, (const bf16_t*)(ws + WS_Q), (size_t)M * (1536 + 1536 + 1024 + 1024), true));
        if (DBG_STOP == 10 * l + 9) DBG_AT(10 * l + 9, dump_bf16(out, (const bf16_t*)(ws + WS_Q), (size_t)M * 1536, true));
        if (DBG_STOP == 10 * l + 8) DBG_AT(10 * l + 8, dump_bf16(out, (const bf16_t*)(ws + WS_AO), (size_t)M * 1024, true));
        REP(5) {
            unsigned char* ws = WSP();
            for (int L = VCU; L < NBATCH * NH * 4; L += GRID_G) {
                const int bh = L >> 2, pr = L & 3;
                att::attn_unit(bh >> 4, bh & 15, 7 - pr, (const bf16_t*)(ws + WS_Q), (const bf16_t*)(ws + WS_KT), (const bf16_t*)(ws + WS_VT), (bf16_t*)(ws + WS_AO) + 1024, (char*)lds_raw);
                att::attn_unit(bh >> 4, bh & 15, pr, (const bf16_t*)(ws + WS_Q), (const bf16_t*)(ws + WS_KT), (const bf16_t*)(ws + WS_VT), (bf16_t*)(ws + WS_AO) + 1024, (char*)lds_raw);
            }
        }
        GRID_BAR();
        if (DBG_STOP == 10 * l + 3) DBG_AT(10 * l + 3, dump_bf16(out, (const bf16_t*)(ws + WS_O), (size_t)M * D, true));
        REP(6) {
            unsigned char* ws = WSP(); unsigned char* wl = ws + WS_WL + l * WL_STRIDE;
            SchedStd S; S.init(M / 256, D / 256, GRID_G, GRID_BX); S.A = (const char*)(ws + WS_AO); S.Bt = (const char*)(wl + WL_PA); S.astep = 256 * (size_t)AOO_LD * 2; S.bstep = 256 * (size_t)(2 * D) * 2;
            EpiProjF E{(const bf16_t*)(ws + WS_G), (bf16_t*)(ws + WS_MG)};
            pg8::gemm_phase<EpiProjF, SchedStd, true, false>(lds, 2 * D, AOO_LD, 2 * D, S, E);
        }
        GRID_BAR();
        if (DBG_STOP == 10 * l + 4) DBG_AT(10 * l + 4, dump_bf16(out, (const bf16_t*)(ws + WS_MG), (size_t)M * D, true));
        REP(7) {
            unsigned char* ws = WSP(); unsigned char* wl = ws + WS_WL + l * WL_STRIDE;
            SchedStd S; S.init(M / 256, D / 256, GRID_G, GRID_BX); S.A = (const char*)(ws + WS_MG); S.Bt = (const char*)(wl + WL_WOUT); S.astep = 256 * (size_t)D * 2; S.bstep = 256 * (size_t)D * 2;
            EpiRes E{(l == 0) ? INP(0) : (const float*)(ws + WS_X2), (l == 0) ? (float*)(ws + WS_X1) : OUTP(), (bf16_t*)(ws + WS_XB), (float*)(ws + WS_XSSP), (MOE_FP8 && l == 1) ? (unsigned char*)(ws + WS_XB8) : nullptr};
            pg8::gemm_phase<EpiRes, SchedStd, false, false>(lds, D, D, D, S, E);
        }
        GRID_BAR();
        if (DBG_STOP == 5 && l == 0) DBG_AT(5, dump_f32(out, (const float*)(ws + WS_X1), (size_t)M * D, true); dump_f32(out, (const float*)(ws + WS_XSSP), (size_t)M * 4, false); dump_bf16(out, (const bf16_t*)(ws + WS_XB), (size_t)M * D, false));
        if (DBG_STOP == 15 && l == 1) return;
        if (l == 0) {
            REP(8) {
                unsigned char* ws = WSP();
                SchedStd S; S.init(M / 256, 2 * FF / 256, GRID_G, GRID_BX); S.A = (const char*)(ws + WS_XB); S.Bt = (const char*)(ws + WS_WGU); S.astep = 256 * (size_t)D * 2; S.bstep = 256 * (size_t)D * 2;
                EpiGU<false> E{(const float*)(ws + WS_XSSP), (bf16_t*)(ws + WS_ACT), nullptr};
                pg8::gemm_phase<EpiGU<false>, SchedStd, true, false>(lds, D, D, D, S, E);
            }
            GRID_BAR();
            DBG_AT(6, dump_bf16(out, (const bf16_t*)(ws + WS_ACT), (size_t)M * FF, true));
            REP(9) {
                unsigned char* ws = WSP();
                SchedStd S; S.init(M / 256, D / 256, GRID_G, GRID_BX); S.A = (const char*)(ws + WS_ACT); S.Bt = (const char*)(ws + WS_WD); S.astep = 256 * (size_t)FF * 2; S.bstep = 256 * (size_t)FF * 2;
                EpiRes E{(const float*)(ws + WS_X1), (float*)(ws + WS_X2), (bf16_t*)(ws + WS_XB), (float*)(ws + WS_XSSP), nullptr};
                pg8::gemm_phase<EpiRes, SchedStd, false, false>(lds, FF, FF, FF, S, E);
            }
            GRID_BAR();
            DBG_AT(7, dump_f32(out, (const float*)(ws + WS_X2), (size_t)M * D, true); dump_f32(out, (const float*)(ws + WS_XSSP), (size_t)M * 4, false));
        } else {
            {
                unsigned char* ws = WSP(); unsigned* ctl = (unsigned*)(ws + WS_CTL);
                int tid = threadIdx.x; asm volatile("" : "+v"(tid)); const int lane = tid & 63, wave = __builtin_amdgcn_readfirstlane(tid >> 6);
                int* idxt = (int*)(ws + WS_IDXT); float* idxw = (float*)(ws + WS_IDXW); const float* xssp = (const float*)(ws + WS_XSSP);
                LAS int* lcnt = (LAS int*)lds; LAS int* lstart = lcnt + 8; LAS int* lsel = lcnt + 16;
                LAS float* lw = (LAS float*)(lcnt + 16 + 128);
                const float* wr_ = INP(19); const float* br_ = INP(20); const float* gf = INP(16) + D; const float* xo = OUTP();
                f32x4 w0r[16], w1r[16];
#pragma unroll
                for (int j = 0; j < 4; ++j)
#pragma unroll
                    for (int i = 0; i < 4; ++i) { const int k = 4 * lane + 256 * j + i; const float gk_ = gf[k];
                        w0r[4 * j + i] = *(const f32x4*)(wr_ + (size_t)k * 8) * gk_; w1r[4 * j + i] = *(const f32x4*)(wr_ + (size_t)k * 8 + 4) * gk_; }
                for (int chunk = GRID_BX; chunk < M / 64; chunk += GRID_G) {
                    if (tid < 8) lcnt[tid] = 0;
                    __syncthreads();
                    u32x2 xn_[4];
#pragma unroll
                    for (int j = 0; j < 4; ++j) xn_[j] = *(const u32x2*)((const bf16_t*)(ws + WS_XB) + (size_t)(chunk * 64 + wave * 8) * D + 4 * lane + 256 * j);
                    f32x4 xsn_ = *(const f32x4*)(xssp + (size_t)(chunk * 64 + wave * 8) * 4);
#pragma unroll 1
                    for (int q = 0; q < 8; ++q) { const int tl = wave * 8 + q; const int tk = chunk * 64 + tl;
                        u32x2 xc_[4];
#pragma unroll
                        for (int j = 0; j < 4; ++j) xc_[j] = xn_[j];
                        const f32x4 xsc_ = xsn_;
                        { const int tkn = tk + (q < 7 ? 1 : 0);
#pragma unroll
                          for (int j = 0; j < 4; ++j) xn_[j] = *(const u32x2*)((const bf16_t*)(ws + WS_XB) + (size_t)tkn * D + 4 * lane + 256 * j);
                          xsn_ = *(const f32x4*)(xssp + (size_t)tkn * 4); }
                        __builtin_amdgcn_sched_barrier(0);
                        float a[8];
#pragma unroll
                        for (int e = 0; e < 8; ++e) a[e] = 0.f;
#pragma unroll
                        for (int j = 0; j < 4; ++j) { const int k0 = 4 * lane + 256 * j;
#if RES_BF16
                            const u32x2 xw_ = xc_[j]; const f32x4 xv = (f32x4){bf_lo(xw_.x), bf_hi(xw_.x), bf_lo(xw_.y), bf_hi(xw_.y)};
#else
                            const f32x4 xv = *(const f32x4*)(xo + (size_t)tk * D + k0) * *(const f32x4*)(gf + k0);
#endif

#pragma unroll
                            for (int i = 0; i < 4; ++i) { const f32x4 w0 = w0r[4 * j + i], w1 = w1r[4 * j + i];
                                a[0] += xv[i] * w0.x; a[1] += xv[i] * w0.y; a[2] += xv[i] * w0.z; a[3] += xv[i] * w0.w; a[4] += xv[i] * w1.x; a[5] += xv[i] * w1.y; a[6] += xv[i] * w1.z; a[7] += xv[i] * w1.w; } }
#pragma unroll
                        for (int e = 0; e < 8; ++e) a[e] = wave_sum(a[e]);
                        if (lane == 0) { const float rs = 1.0f / sqrtf(sum4(xsc_) * (1.0f / D) + EPS);
                            float lg[8];
#pragma unroll
                            for (int e = 0; e < 8; ++e) lg[e] = a[e] * rs + br_[e];
                            int e0 = 0; float v0 = lg[0];
#pragma unroll
                            for (int e = 1; e < 8; ++e) if (lg[e] > v0) { v0 = lg[e]; e0 = e; }
                            int e1 = -1; float v1 = -INFINITY;
#pragma unroll
                            for (int e = 0; e < 8; ++e) if (e != e0 && lg[e] > v1) { v1 = lg[e]; e1 = e; }
                            const float w1v = 1.0f / (1.0f + expf(v0 - v1)), w0v = 1.0f - w1v;
                            const int i0 = atomicAdd((int*)&lcnt[e0], 1), i1 = atomicAdd((int*)&lcnt[e1], 1);
                            lsel[tl * 2] = e0 | (i0 << 8); lsel[tl * 2 + 1] = e1 | (i1 << 8); lw[tl * 2] = w0v; lw[tl * 2 + 1] = w1v; }
                    }
                    __syncthreads();
                    if (tid < 8) lstart[tid] = (int)atomicAdd(ctl + CW_CNT + 64 * tid, (unsigned)lcnt[tid]);
                    __syncthreads();
                    if (tid < 128) { const int sel = lsel[tid]; const int e = sel & 255, li = sel >> 8; const int pos = lstart[e] + li;
                        const int tk_ = chunk * 64 + (tid >> 1); idxt[e * M + pos] = tk_; idxw[e * M + pos] = lw[tid]; ((int*)(ws + WS_TOKPOS))[chunk * 128 + tid] = e | (pos << 4);
                        ((float*)(ws + WS_IDXR))[e * M + pos] = frsq(sum4(*(const f32x4*)(xssp + (size_t)tk_ * 4)) * (1.0f / D) + EPS) * (1.0f / W8_SCALE); }
                    __syncthreads();
                }
            }
            GRID_BAR();
            REP(10) {
                unsigned char* ws = WSP(); unsigned* ctl = (unsigned*)(ws + WS_CTL);
                moe_table_build(lds, ctl + CW_CNT);
                SchedMoeGu S; S.tt = lds + MOE_TT_OFF; S.init(moe_table_tiles(lds), 2 * FF / 256, GRID_G, GRID_BX); S.XB = (const char*)(ws + (MOE_FP8 ? WS_XB8 : WS_XB)); S.W = (const char*)(ws + WS_MGU); S.idxt = (const int*)(ws + WS_IDXT);
                EpiGU<true> E{(const float*)(ws + WS_XSSP), (bf16_t*)(ws + WS_ACT2), (const float*)(ws + WS_IDXR)};
#if MOE_FP8
                pg8::gemm_phase_f8<EpiGU<true>, SchedMoeGu, true, true>(lds, D, D, D, S, E);
#else
                pg8::gemm_phase<EpiGU<true>, SchedMoeGu, true, true>(lds, D, D, D, S, E);
#endif
            }
            GRID_BAR();
            REP(11) {
                unsigned char* ws = WSP(); unsigned* ctl = (unsigned*)(ws + WS_CTL);
                moe_table_build(lds, ctl + CW_CNT);
                SchedMoeDn S; S.tt = lds + MOE_TT_OFF; S.init(moe_table_tiles(lds), GRID_G, GRID_BX); S.A = (const char*)(ws + WS_ACT2); S.W = (const char*)(ws + WS_MD);
                EpiMoeDn E{(bf16_t*)(ws + WS_Y), (const float*)(ws + WS_IDXW)};
#if MOE_FP8
                pg8::gemm_phase_f8<EpiMoeDn, SchedMoeDn, true, false>(lds, FF / 2, FF, FF, S, E);
#else
                pg8::gemm_phase<EpiMoeDn, SchedMoeDn, true, false>(lds, FF / 2, FF, FF, S, E);
#endif
            }
            GRID_BAR();
            {
                unsigned char* ws = WSP(); const unsigned* cntw = (const unsigned*)(ws + WS_CTL) + CW_CNT;
                int tid = threadIdx.x; asm volatile("" : "+v"(tid)); const int lane = tid & 63, wave = __builtin_amdgcn_readfirstlane(tid >> 6);
                int tsv[8]; { int a_ = 0, c_[8];
#pragma unroll
                    for (int e = 0; e < 8; ++e) c_[e] = (int)__hip_atomic_load(cntw + 64 * e, __ATOMIC_RELAXED, __HIP_MEMORY_SCOPE_AGENT);
                    __builtin_amdgcn_sched_barrier(0);
#pragma unroll
                    for (int e = 0; e < 8; ++e) { tsv[e] = a_ * 256; a_ += (__builtin_amdgcn_readfirstlane(c_[e]) + 255) >> 8; } }
                const int* tokpos = (const int*)(ws + WS_TOKPOS); const bf16_t* Y = (const bf16_t*)(ws + WS_Y); float* out = OUTP();
                for (int tk0 = (VCU * 8 + wave) * 4; tk0 < M; tk0 += GRID_G * 32) {
                    size_t s0[4], s1[4];
                    int tpv[4][2];
#pragma unroll
                    for (int q = 0; q < 4; ++q) { tpv[q][0] = tokpos[2 * (tk0 + q)]; tpv[q][1] = tokpos[2 * (tk0 + q) + 1]; }
                    __builtin_amdgcn_sched_barrier(0);
#pragma unroll
                    for (int q = 0; q < 4; ++q) { const int tp0 = tpv[q][0], tp1 = tpv[q][1]; int b0 = 0, b1 = 0;
#pragma unroll
                        for (int e = 0; e < 8; ++e) { if ((tp0 & 15) == e) b0 = tsv[e]; if ((tp1 & 15) == e) b1 = tsv[e]; }
                        s0[q] = (size_t)(b0 + (tp0 >> 4)) * D; s1[q] = (size_t)(b1 + (tp1 >> 4)) * D; }
#pragma unroll
                    for (int q = 0; q < 4; ++q) {
#pragma unroll
                      for (int j = 0; j < 2; ++j) { const int c = 8 * lane + 512 * j;
                        const u32x4 zz = {0u, 0u, 0u, 0u}; const size_t split0 = (size_t)128 * 256 * D;
                        const u32x4 y0 = ld_nt(Y + s0[q] + c), y1 = (s0[q] >= split0) ? ld_nt(Y + (size_t)SLOTS * D + s0[q] + c) : zz, y2 = ld_nt(Y + s1[q] + c), y3 = (s1[q] >= split0) ? ld_nt(Y + (size_t)SLOTS * D + s1[q] + c) : zz;
                        float* o = out + (size_t)(tk0 + q) * D + c;
#if RES_BF16
                        const u32x4 xr = ld_nt((const bf16_t*)(ws + WS_XB) + (size_t)(tk0 + q) * D + c); f32x4 a = {bf_lo(xr.x), bf_hi(xr.x), bf_lo(xr.y), bf_hi(xr.y)}, b = {bf_lo(xr.z), bf_hi(xr.z), bf_lo(xr.w), bf_hi(xr.w)};
#else
                        f32x4 a = *(const f32x4*)o, b = *(const f32x4*)(o + 4);
#endif
                        a.x += (bf_lo(y0.x) + bf_lo(y1.x)) + (bf_lo(y2.x) + bf_lo(y3.x)); a.y += (bf_hi(y0.x) + bf_hi(y1.x)) + (bf_hi(y2.x) + bf_hi(y3.x));
                        a.z += (bf_lo(y0.y) + bf_lo(y1.y)) + (bf_lo(y2.y) + bf_lo(y3.y)); a.w += (bf_hi(y0.y) + bf_hi(y1.y)) + (bf_hi(y2.y) + bf_hi(y3.y));
                        b.x += (bf_lo(y0.z) + bf_lo(y1.z)) + (bf_lo(y2.z) + bf_lo(y3.z)); b.y += (bf_hi(y0.z) + bf_hi(y1.z)) + (bf_hi(y2.z) + bf_hi(y3.z));
                        b.z += (bf_lo(y0.w) + bf_lo(y1.w)) + (bf_lo(y2.w) + bf_lo(y3.w)); b.w += (bf_hi(y0.w) + bf_hi(y1.w)) + (bf_hi(y2.w) + bf_hi(y3.w));
                        *(f32x4*)o = a; *(f32x4*)(o + 4) = b; } }
                }
            }
        }
    }
}

extern "C" void kernel_launch(void* const* d_in, const int* in_sizes, int n_in, void* d_out, int out_size, void* d_ws, size_t ws_size, hipStream_t stream) {
    static int grid = 0;
    if (grid == 0) {
        if (n_in != 23 || out_size != M * D || ws_size < WS_END) { fprintf(stderr, "kernel_launch: unexpected arguments (n_in %d out %d ws %zu)\n", n_in, out_size, ws_size); grid = -1; return; }
        int dev = 0, cus = 0, per_cu = 0;
        if (hipGetDevice(&dev) != hipSuccess || hipDeviceGetAttribute(&cus, hipDeviceAttributeMultiprocessorCount, dev) != hipSuccess) { grid = -1; return; }
        if (hipFuncSetAttribute((const void*)fwd_kernel, hipFuncAttributeMaxDynamicSharedMemorySize, LDS_BYTES) != hipSuccess) { fprintf(stderr, "kernel_launch: hipFuncSetAttribute failed\n"); grid = -1; return; }
        if (hipOccupancyMaxActiveBlocksPerMultiprocessor(&per_cu, (const void*)fwd_kernel, 512, LDS_BYTES) != hipSuccess || per_cu < 1) { fprintf(stderr, "kernel_launch: occupancy query says %d\n", per_cu); }
        (void)hipGetLastError();
        grid = cus;
    }
    if (grid < 0) return;
    (void)hipMemsetAsync((char*)d_ws + WS_CTL, 0, CTL_ZERO_BYTES, stream);
    Params p{};
    for (int i = 0; i < 23; ++i) p.in[i] = (const float*)d_in[i];
    p.out = (float*)d_out; p.ws = (unsigned char*)d_ws;
#if DBG_TWO
    p.mode = 1; hipLaunchKernelGGL(fwd_kernel, dim3(grid), dim3(512), LDS_BYTES, stream, p);
    (void)hipMemsetAsync((char*)d_ws + WS_CTL, 0, CTL_ZERO_BYTES, stream);
    p.mode = 2; hipLaunchKernelGGL(fwd_kernel, dim3(grid), dim3(512), LDS_BYTES, stream, p);
#else
    hipLaunchKernelGGL(fwd_kernel, dim3(grid), dim3(512), LDS_BYTES, stream, p);
#endif
}
```
